# Optimizing an MI355X kernel written in HIP

```python
import math
import jax, jax.numpy as jnp
from jax import lax
import numpy as np

D_MODEL = 2048
BATCH = 4
SEQ = 4096
DEPTH = 1

N_Q_HEADS = 16
N_KV_HEADS = 4
HEAD_DIM = 64
WINDOW = 128
ATTN_BLOCK = 128
ATTN_WIDTH = N_Q_HEADS * HEAD_DIM
KV_WIDTH = N_KV_HEADS * HEAD_DIM
REL_BUCKETS = 32
REL_MAX_DIST = 128
HG_HEADS = 8
HG_KEY_DIM = 128
HG_VAL_DIM = 128
HG_KEY_WIDTH = HG_HEADS * HG_KEY_DIM
HG_VAL_WIDTH = HG_HEADS * HG_VAL_DIM
HG_CHUNK = 64
N_GROUPS = 4
EXPERTS_PER_GROUP = 8
N_EXPERTS = N_GROUPS * EXPERTS_PER_GROUP
TOP_K = 2
EXPERT_FF = 512
MOE_BLOCK = 128
RMS_EPS = 1e-6
IN_SECTIONS = (ATTN_WIDTH, KV_WIDTH, KV_WIDTH, HG_KEY_WIDTH, HG_KEY_WIDTH, HG_VAL_WIDTH, HG_VAL_WIDTH, D_MODEL, D_MODEL)
IN_WIDTH = ATTN_WIDTH + 2 * KV_WIDTH + 2 * HG_KEY_WIDTH + 2 * HG_VAL_WIDTH + 2 * D_MODEL

kernel_name = 'hybrid_swa_sink_hgrn2_hiermoe'


def rms_norm(x, g):
    xf = x.astype(jnp.float32)
    y = xf * lax.rsqrt(jnp.mean(xf * xf, axis=-1, keepdims=True) + RMS_EPS)
    return (y * g.astype(jnp.float32)).astype(x.dtype)


def t5_causal_bucket(n):
    max_exact = REL_BUCKETS // 2
    nf = jnp.maximum(n, 1).astype(jnp.float32)
    large = max_exact + (jnp.log(nf / max_exact) / math.log(REL_MAX_DIST / max_exact)
                         * (REL_BUCKETS - max_exact)).astype(jnp.int32)
    large = jnp.minimum(large, REL_BUCKETS - 1)
    return jnp.where(n < max_exact, n, large)


def sliding_window_sink_attention(q, k, v, sinks, rel_table):
    bsz, s_len, _ = q.shape
    nb = s_len // ATTN_BLOCK
    grp = N_Q_HEADS // N_KV_HEADS
    q = q.reshape(bsz, nb, ATTN_BLOCK, N_KV_HEADS, grp, HEAD_DIM)
    k = k.reshape(bsz, nb, ATTN_BLOCK, N_KV_HEADS, HEAD_DIM)
    v = v.reshape(bsz, nb, ATTN_BLOCK, N_KV_HEADS, HEAD_DIM)
    pad_k = jnp.zeros_like(k[:, :1])
    kk = jnp.concatenate([jnp.concatenate([pad_k, k[:, :-1]], axis=1), k], axis=2)
    vv = jnp.concatenate([jnp.concatenate([pad_k, v[:, :-1]], axis=1), v], axis=2)
    s = jnp.einsum('bnqhgd,bnkhd->bnhgqk', q, kk).astype(jnp.float32) * (HEAD_DIM ** -0.5)
    qi = jnp.arange(ATTN_BLOCK)[:, None]
    kj = jnp.arange(2 * ATTN_BLOCK)[None, :]
    dist = qi + ATTN_BLOCK - kj
    bias = rel_table[t5_causal_bucket(jnp.clip(dist, 0))]
    bias = bias.transpose(2, 0, 1).reshape(N_KV_HEADS, grp, ATTN_BLOCK, 2 * ATTN_BLOCK).astype(jnp.float32)
    valid = (dist >= 0) & (dist < WINDOW)
    in_range = (jnp.arange(nb)[:, None, None] > 0) | (kj >= ATTN_BLOCK)[None]
    valid = valid[None] & in_range
    s = jnp.where(valid[None, :, None, None], s + bias, -jnp.inf)
    sink = sinks.astype(jnp.float32).reshape(N_KV_HEADS, grp, 1, 1)
    m = jnp.maximum(jnp.max(s, axis=-1, keepdims=True), sink)
    p = jnp.exp(s - m)
    denom = jnp.sum(p, axis=-1, keepdims=True) + jnp.exp(sink - m)
    o = jnp.einsum('bnhgqk,bnkhd->bnqhgd', (p / denom).astype(vv.dtype), vv)
    return o.reshape(bsz, s_len, ATTN_WIDTH)


def hgrn2(q, f_raw, i_in, g_out, lb, gn):
    bsz, s_len, _ = q.shape
    nc = s_len // HG_CHUNK
    f = lb + (1.0 - lb) * jax.nn.sigmoid(f_raw.astype(jnp.float32))
    logf = jnp.log(f)
    kf = 1.0 - f

    def heads(t, d):
        return t.astype(jnp.float32).reshape(bsz, nc, HG_CHUNK, HG_HEADS, d).transpose(1, 0, 3, 2, 4)

    qc, kc, gc = heads(q, HG_KEY_DIM), heads(kf, HG_KEY_DIM), heads(logf, HG_KEY_DIM)
    vc = heads(i_in, HG_VAL_DIM)
    tri = jnp.tril(jnp.ones((HG_CHUNK, HG_CHUNK), dtype=bool))

    def step(state, inp):
        qt, kt, vt, gt = inp
        b = jnp.cumsum(gt, axis=2)
        o_inter = jnp.einsum('bhtk,bhkv->bhtv', qt * jnp.exp(b), state)
        decay = jnp.exp(jnp.where(tri[None, None, :, :, None], b[:, :, :, None, :] - b[:, :, None, :, :], -jnp.inf))
        att = jnp.einsum('bhtk,bhsk,bhtsk->bhts', qt, kt, decay)
        o = o_inter + jnp.einsum('bhts,bhsv->bhtv', att, vt)
        b_last = b[:, :, -1]
        state = jnp.exp(b_last)[..., None] * state + jnp.einsum('bhsk,bhsv->bhkv', kt * jnp.exp(b_last[:, :, None] - b), vt)
        return state, o

    s0 = jnp.zeros((bsz, HG_HEADS, HG_KEY_DIM, HG_VAL_DIM), jnp.float32)
    _, o = lax.scan(step, s0, (qc, kc, vc, gc))
    o = o.transpose(1, 0, 3, 2, 4).reshape(bsz, s_len, HG_HEADS, HG_VAL_DIM)
    o = o * lax.rsqrt(jnp.mean(o * o, axis=-1, keepdims=True) + RMS_EPS) * gn.astype(jnp.float32)
    o = o * jax.nn.silu(g_out.astype(jnp.float32).reshape(bsz, s_len, HG_HEADS, HG_VAL_DIM))
    return o.reshape(bsz, s_len, HG_VAL_WIDTH).astype(q.dtype)


def hier_moe(h, w_gr, b_gr, w_er, b_er, w_gate, w_up, w_down):
    bsz, s_len, d = h.shape
    n_tok = bsz * s_len
    t = h.reshape(n_tok, d)
    gl = (t @ w_gr).astype(jnp.float32) + b_gr.astype(jnp.float32)
    gp = jax.nn.softmax(gl, axis=-1)
    g_idx = jnp.argmax(gl, axis=-1)
    g_w = jnp.take_along_axis(gp, g_idx[:, None], axis=1)[:, 0]
    el = ((t @ w_er).astype(jnp.float32) + b_er.astype(jnp.float32)).reshape(n_tok, N_GROUPS, EXPERTS_PER_GROUP)
    el_sel = jnp.take_along_axis(el, g_idx[:, None, None], axis=1)[:, 0]
    ep = jax.nn.softmax(el_sel, axis=-1)
    top_p, top_i = lax.top_k(ep, TOP_K)
    wts = g_w[:, None] * top_p / jnp.sum(top_p, axis=-1, keepdims=True)
    e_id = (g_idx[:, None] * EXPERTS_PER_GROUP + top_i).astype(jnp.int32)
    n_asg = n_tok * TOP_K
    e_flat = e_id.reshape(n_asg)
    w_flat = wts.reshape(n_asg)
    tok = jnp.repeat(jnp.arange(n_tok, dtype=jnp.int32), TOP_K)
    order = jnp.argsort(e_flat)
    e_s, tok_s, w_s = e_flat[order], tok[order], w_flat[order]
    counts = jnp.bincount(e_flat, length=N_EXPERTS)
    padded = (counts + MOE_BLOCK - 1) // MOE_BLOCK * MOE_BLOCK
    starts = jnp.cumsum(counts) - counts
    pends = jnp.cumsum(padded)
    pstarts = pends - padded
    dest = pstarts[e_s] + jnp.arange(n_asg, dtype=jnp.int32) - starts[e_s]
    n_blocks = -(-n_asg // MOE_BLOCK) + N_EXPERTS
    n_rows = n_blocks * MOE_BLOCK
    row_tok = jnp.full((n_rows,), n_tok, jnp.int32).at[dest].set(tok_s)
    row_w = jnp.zeros((n_rows,), jnp.float32).at[dest].set(w_s)
    block_e = jnp.minimum(jnp.searchsorted(pends, jnp.arange(n_blocks) * MOE_BLOCK, side='right'), N_EXPERTS - 1)
    t_pad = jnp.concatenate([t, jnp.zeros((1, d), t.dtype)], axis=0)

    def expert_block(args):
        idx, eid = args
        xb = t_pad[idx]
        hb = jax.nn.silu(xb @ w_gate[eid]) * (xb @ w_up[eid])
        return hb @ w_down[eid]

    yb = lax.map(expert_block, (row_tok.reshape(n_blocks, MOE_BLOCK), block_e))
    yb = yb.reshape(n_rows, d) * row_w[:, None].astype(yb.dtype)
    y = jax.ops.segment_sum(yb, row_tok, num_segments=n_tok + 1)[:n_tok]
    return y.reshape(bsz, s_len, d)


def setup_inputs(seed: int = 0) -> dict:
    key = jax.random.key(seed)
    ks = jax.random.split(key, 20)
    f32 = jnp.float32
    nrm = lambda k, shp, sc: jax.random.normal(k, shp, f32) * sc
    return {
        'x': nrm(ks[0], (BATCH, SEQ, D_MODEL), 1.0),
        'norm1_g': 1.0 + nrm(ks[1], (DEPTH, D_MODEL), 0.02),
        'w_in': nrm(ks[2], (DEPTH, D_MODEL, IN_WIDTH), D_MODEL ** -0.5),
        'attn_sinks': nrm(ks[3], (DEPTH, N_Q_HEADS), 0.5),
        'rel_bias': nrm(ks[4], (REL_BUCKETS, N_Q_HEADS), 0.5),
        'hg_lb_logits': nrm(ks[5], (DEPTH + 1, HG_KEY_WIDTH), 0.5),
        'hg_norm_g': 1.0 + nrm(ks[6], (DEPTH, HG_VAL_DIM), 0.02),
        'w_attn_branch': nrm(ks[7], (DEPTH, ATTN_WIDTH, D_MODEL), ATTN_WIDTH ** -0.5),
        'w_hg_branch': nrm(ks[8], (DEPTH, HG_VAL_WIDTH, D_MODEL), HG_VAL_WIDTH ** -0.5),
        'w_out': nrm(ks[9], (DEPTH, D_MODEL, D_MODEL), D_MODEL ** -0.5),
        'norm2_g': 1.0 + nrm(ks[10], (DEPTH, D_MODEL), 0.02),
        'w_group_router': nrm(ks[11], (DEPTH, D_MODEL, N_GROUPS), D_MODEL ** -0.5),
        'b_group_router': nrm(ks[12], (DEPTH, N_GROUPS), 0.01),
        'w_expert_router': nrm(ks[13], (DEPTH, D_MODEL, N_EXPERTS), D_MODEL ** -0.5),
        'b_expert_router': nrm(ks[14], (DEPTH, N_EXPERTS), 0.01),
        'w_gate': nrm(ks[15], (DEPTH, N_EXPERTS, D_MODEL, EXPERT_FF), D_MODEL ** -0.5),
        'w_up': nrm(ks[16], (DEPTH, N_EXPERTS, D_MODEL, EXPERT_FF), D_MODEL ** -0.5),
        'w_down': nrm(ks[17], (DEPTH, N_EXPERTS, EXPERT_FF, D_MODEL), EXPERT_FF ** -0.5),
        'final_g': 1.0 + nrm(ks[18], (D_MODEL,), 0.02),
    }


def reference(x, norm1_g, w_in, attn_sinks, rel_bias, hg_lb_logits, hg_norm_g, w_attn_branch, w_hg_branch,
              w_out, norm2_g, w_group_router, b_group_router, w_expert_router, b_expert_router,
              w_gate, w_up, w_down, final_g):
    lb_all = jnp.cumsum(jax.nn.softmax(hg_lb_logits.astype(jnp.float32), axis=0), axis=0)
    offsets = [int(v) for v in np.cumsum(IN_SECTIONS)[:-1]]
    for l in range(DEPTH):
        h = rms_norm(x, norm1_g[l])
        proj = h @ w_in[l]
        q_a, k_a, v_a, q_h, f_h, i_h, g_h, gate_a, gate_h = jnp.split(proj, offsets, axis=-1)
        a = sliding_window_sink_attention(q_a, k_a, v_a, attn_sinks[l], rel_bias)
        r = hgrn2(q_h, f_h, i_h, g_h, lb_all[l], hg_norm_g[l])
        mixed = jax.nn.sigmoid(gate_a) * (a @ w_attn_branch[l]) + jax.nn.sigmoid(gate_h) * (r @ w_hg_branch[l])
        x = x + mixed @ w_out[l]
        h2 = rms_norm(x, norm2_g[l])
        x = x + hier_moe(h2, w_group_router[l], b_group_router[l], w_expert_router[l], b_expert_router[l],
                         w_gate[l], w_up[l], w_down[l])
    return rms_norm(x, final_g)
```

```cpp
#include <hip/hip_runtime.h>
#include <stdint.h>
#include <cstdio>

constexpr int NTOK = 16384, DM = 2048, SEQ = 4096, NB = 4;
constexpr int INW = 9728;
constexpr int AW = 1024, KVW = 256, HKW = 1024, HVW = 1024;
constexpr int NEXP = 32, NGRP = 4, EPG = 8, EFF = 512;
constexpr float EPS = 1e-6f;
constexpr int LIST_CAP = 32768;

typedef unsigned short bf16_t;
__device__ __forceinline__ float bf2f(bf16_t v) { return __uint_as_float(((unsigned)v) << 16); }
__device__ __forceinline__ bf16_t f2bf(float f) { unsigned u = __float_as_uint(f); u += 0x7fffu + ((u >> 16) & 1u); return (bf16_t)(u >> 16); }
__device__ __forceinline__ float sigmoidf_(float x) { return 1.f / (1.f + __expf(-x)); }

constexpr size_t MiB = 1u << 20;
constexpr size_t WS_CTL = 0;
constexpr size_t WS_RS1 = 1 * MiB;
constexpr size_t WS_RS2 = 1 * MiB + 65536;
constexpr size_t WS_LB = 1 * MiB + 131072;
constexpr size_t WS_EID = 2 * MiB;
constexpr size_t WS_EW = 2 * MiB + 131072;
constexpr size_t WS_WRH = 2 * MiB + 262144, WS_WRL = 2 * MiB + 524288;
constexpr size_t WS_LIST = 3 * MiB;
constexpr size_t WS_WIN = 8 * MiB, WS_WAR = 46 * MiB, WS_WOUT = 54 * MiB, WS_WGU = 62 * MiB, WS_WDN = 190 * MiB;
constexpr size_t WS_QA = 254 * MiB, WS_KA = 286 * MiB, WS_VA = 294 * MiB, WS_QH = 302 * MiB, WS_GH = 334 * MiB, WS_IH = 398 * MiB, WS_GO = 430 * MiB;
constexpr size_t WS_SGA = 462 * MiB, WS_SGB = 526 * MiB;
constexpr size_t WS_HST = 590 * MiB;
constexpr size_t WS_END = 608 * MiB;
constexpr size_t WS_MIX = 254 * MiB, WS_XB2 = 318 * MiB, WS_HB = 382 * MiB;
constexpr size_t WS_YB = 462 * MiB;
constexpr size_t WS_WIN8 = WS_WIN + 22 * MiB;
constexpr size_t WS_XF2 = WS_WGU + 64 * MiB;
constexpr size_t WS_LISTW = WS_HST + 2 * MiB, WS_LISTR = WS_HST + 6 * MiB;
constexpr size_t WS_SS2P = WS_HST;

struct Params {
    const float *x, *norm1_g, *w_in, *sinks, *rel_bias, *lb_logits, *hg_norm_g, *w_a, *w_r, *w_out, *norm2_g, *w_gr, *b_gr, *w_er, *b_er, *w_gate, *w_up, *w_down, *final_g;
    float* out; unsigned char* ws;
};

__device__ __forceinline__ float wave_sum(float v) {
#pragma unroll
    for (int o = 1; o < 64; o <<= 1) v += __shfl_xor(v, o);
    return v;
}

__global__ void __launch_bounds__(256) bl_rowstat(Params p) {
    const int lane = threadIdx.x & 63, gw = (blockIdx.x * 256 + threadIdx.x) >> 6, ngw = (gridDim.x * 256) >> 6;
    float* rs1 = (float*)(p.ws + WS_RS1);
    for (int r = gw; r < NTOK; r += ngw) {
        const float* xr = p.x + (size_t)r * DM; float s = 0.f;
        for (int i = lane; i < DM; i += 64) { float v = xr[i]; s += v * v; }
        s = wave_sum(s);
        if (lane == 0) rs1[r] = 1.f / sqrtf(s * (1.f / DM) + EPS);
    }
    if (blockIdx.x == 0) {
        float* lb = (float*)(p.ws + WS_LB);
        for (int j = threadIdx.x; j < HKW; j += 256) { float l0 = p.lb_logits[j], l1 = p.lb_logits[HKW + j]; lb[j] = 1.f / (1.f + __expf(l1 - l0)); }
    }
    if (blockIdx.x == 1 && threadIdx.x < 64) ((int*)(p.ws + WS_CTL))[threadIdx.x] = 0;
}

struct RowDesc { const void* p; float s; };

template <class AL, class BL, class EP, bool DUAL>
__device__ __forceinline__ void bl_gemm_tile(const AL& al, const BL& bl, const EP& ep, int m0, int n0, int K, float (*As)[132], float (*Bs)[132], float (*Bs2)[132]) {
    const int tid = threadIdx.x, tx = tid & 15, ty = tid >> 4;
    float acc[8][8], acc2[DUAL ? 8 : 1][8];
#pragma unroll
    for (int i = 0; i < 8; ++i)
#pragma unroll
        for (int j = 0; j < 8; ++j) { acc[i][j] = 0.f; if (DUAL) acc2[i][j] = 0.f; }
    RowDesc rd[4];
#pragma unroll
    for (int i = 0; i < 4; ++i) rd[i] = al.row(m0 + (tid >> 3) + 32 * i);
    const int ak = tid & 7;
    for (int k0 = 0; k0 < K; k0 += 8) {
        float av[4], bv[4], bv2[4];
#pragma unroll
        for (int i = 0; i < 4; ++i) av[i] = al.ld(rd[i], k0 + ak);
#pragma unroll
        for (int i = 0; i < 4; ++i) { const int idx = tid + 256 * i, kk = idx >> 7, cc = idx & 127; bv[i] = bl.ld(k0 + kk, n0 + cc); if (DUAL) bv2[i] = bl.ld2(k0 + kk, n0 + cc); }
        __syncthreads();
#pragma unroll
        for (int i = 0; i < 4; ++i) As[ak][(tid >> 3) + 32 * i] = av[i];
#pragma unroll
        for (int i = 0; i < 4; ++i) { const int idx = tid + 256 * i, kk = idx >> 7, cc = idx & 127; Bs[kk][cc] = bv[i]; if (DUAL) Bs2[kk][cc] = bv2[i]; }
        __syncthreads();
#pragma unroll
        for (int kk = 0; kk < 8; ++kk) {
            float a[8], b[8], b2[8];
#pragma unroll
            for (int i = 0; i < 8; ++i) a[i] = As[kk][ty * 8 + i];
#pragma unroll
            for (int j = 0; j < 8; ++j) { b[j] = Bs[kk][tx * 8 + j]; if (DUAL) b2[j] = Bs2[kk][tx * 8 + j]; }
#pragma unroll
            for (int i = 0; i < 8; ++i)
#pragma unroll
                for (int j = 0; j < 8; ++j) { acc[i][j] += a[i] * b[j]; if (DUAL) acc2[i][j] += a[i] * b2[j]; }
        }
    }
#pragma unroll
    for (int i = 0; i < 8; ++i)
#pragma unroll
        for (int j = 0; j < 8; ++j) ep(m0 + ty * 8 + i, n0 + tx * 8 + j, acc[i][j], DUAL ? acc2[i][j] : 0.f);
}

struct ALx { const float* x; const float* rs; const float* g;
    __device__ RowDesc row(int m) const { RowDesc d; d.p = x + (size_t)m * DM; d.s = rs[m]; return d; }
    __device__ float ld(const RowDesc& d, int k) const { return ((const float*)d.p)[k] * d.s * g[k]; } };
struct ALbf { const bf16_t* a; int lda;
    __device__ RowDesc row(int m) const { RowDesc d; d.p = a + (size_t)m * lda; d.s = 1.f; return d; }
    __device__ float ld(const RowDesc& d, int k) const { return bf2f(((const bf16_t*)d.p)[k]); } };
struct BLf { const float* b; int ldb;
    __device__ float ld(int k, int n) const { return b[(size_t)k * ldb + n]; }
    __device__ float ld2(int k, int n) const { return 0.f; } };

struct EpG1 { unsigned char* ws; const float* rs1; const float* lb;
    __device__ void operator()(int m, int c, float acc, float) const {
        const float v = acc * rs1[m];
        if (c < 1024) ((bf16_t*)(ws + WS_QA))[(size_t)m * 1024 + c] = f2bf(v * 0.125f);
        else if (c < 1280) ((bf16_t*)(ws + WS_KA))[(size_t)m * 256 + c - 1024] = f2bf(v);
        else if (c < 1536) ((bf16_t*)(ws + WS_VA))[(size_t)m * 256 + c - 1280] = f2bf(v);
        else if (c < 2560) ((bf16_t*)(ws + WS_QH))[(size_t)m * 1024 + c - 1536] = f2bf(v);
        else if (c < 3584) { const int j = c - 2560; const float l = lb[j], f = l + (1.f - l) * sigmoidf_(v); ((float*)(ws + WS_GH))[(size_t)m * 1024 + j] = __logf(f); }
        else if (c < 4608) ((bf16_t*)(ws + WS_IH))[(size_t)m * 1024 + c - 3584] = f2bf(v);
        else if (c < 5632) ((bf16_t*)(ws + WS_GO))[(size_t)m * 1024 + c - 4608] = f2bf(v);
        else if (c < 7680) ((bf16_t*)(ws + WS_SGA))[(size_t)m * 2048 + c - 5632] = f2bf(sigmoidf_(v));
        else ((bf16_t*)(ws + WS_SGB))[(size_t)m * 2048 + c - 7680] = f2bf(sigmoidf_(v));
    } };

__global__ void __launch_bounds__(256) bl_g1(Params p) {
    __shared__ float As[8][132], Bs[8][132];
    ALx al{p.x, (const float*)(p.ws + WS_RS1), p.norm1_g}; BLf bl{p.w_in, INW}; EpG1 ep{p.ws, (const float*)(p.ws + WS_RS1), (const float*)(p.ws + WS_LB)};
    bl_gemm_tile<ALx, BLf, EpG1, false>(al, bl, ep, blockIdx.y * 128, blockIdx.x * 128, DM, As, Bs, nullptr);
}

__device__ __constant__ unsigned char T5B[128] = {0, 1, 2, 3, 4, 5, 6, 7, 8, 9, 10, 11, 12, 13, 14, 15, 16, 16, 16, 17, 17, 18, 18, 18, 19, 19, 19, 20, 20, 20, 20, 21, 21, 21, 21, 22, 22, 22, 22, 22, 23, 23, 23, 23, 23, 23, 24, 24, 24, 24, 24, 24, 25, 25, 25, 25, 25, 25, 25, 26, 26, 26, 26, 26, 26, 26, 26, 27, 27, 27, 27, 27, 27, 27, 27, 27, 27, 28, 28, 28, 28, 28, 28, 28, 28, 28, 28, 29, 29, 29, 29, 29, 29, 29, 29, 29, 29, 29, 29, 30, 30, 30, 30, 30, 30, 30, 30, 30, 30, 30, 30, 30, 30, 31, 31, 31, 31, 31, 31, 31, 31, 31, 31, 31, 31, 31, 31, 31};

__global__ void __launch_bounds__(256) bl_attn(Params p) {
    const int gid = blockIdx.x * 256 + threadIdx.x;
    const int tok = gid >> 4, h = gid & 15, kvh = h >> 2, b = tok / SEQ, pos = tok % SEQ;
    const bf16_t* QA = (const bf16_t*)(p.ws + WS_QA); const bf16_t* KA = (const bf16_t*)(p.ws + WS_KA); const bf16_t* VA = (const bf16_t*)(p.ws + WS_VA);
    bf16_t* AR = (bf16_t*)((unsigned char*)p.out + 64 * MiB);
    float q[64], o[64];
#pragma unroll
    for (int d = 0; d < 64; ++d) { q[d] = bf2f(QA[(size_t)tok * 1024 + h * 64 + d]); o[d] = 0.f; }
    float m = p.sinks[h], l = 1.f;
    const int blk0 = (pos / 128) * 128;
    int lo = pos - 127; if (lo < 0) lo = 0; if (lo < blk0 - 128) lo = blk0 - 128;
    for (int kp = lo; kp <= pos; ++kp) {
        const size_t kr = (size_t)(b * SEQ + kp) * 256 + kvh * 64;
        float s = 0.f;
#pragma unroll
        for (int d = 0; d < 64; ++d) s += q[d] * bf2f(KA[kr + d]);
        s += p.rel_bias[T5B[pos - kp] * 16 + h];
        const float mn = fmaxf(m, s), sc = __expf(m - mn), pe = __expf(s - mn);
        l = l * sc + pe;
#pragma unroll
        for (int d = 0; d < 64; ++d) o[d] = o[d] * sc + pe * bf2f(VA[kr + d]);
        m = mn;
    }
    const float inv = 1.f / l;
#pragma unroll
    for (int d = 0; d < 64; ++d) AR[(size_t)tok * 2048 + h * 64 + d] = f2bf(o[d] * inv);
}

__global__ void __launch_bounds__(128) bl_hgrn(Params p) {
    const int b = blockIdx.x >> 3, h = blockIdx.x & 7, v = threadIdx.x;
    const bf16_t* QH = (const bf16_t*)(p.ws + WS_QH); const float* GH = (const float*)(p.ws + WS_GH); const bf16_t* IH = (const bf16_t*)(p.ws + WS_IH); const bf16_t* GO = (const bf16_t*)(p.ws + WS_GO);
    bf16_t* AR = (bf16_t*)((unsigned char*)p.out + 64 * MiB);
    __shared__ float sq[8][128], sf[8][128], red[2];
    float S[128];
#pragma unroll
    for (int k = 0; k < 128; ++k) S[k] = 0.f;
    const float gn = p.hg_norm_g[v];
    for (int t0 = 0; t0 < SEQ; t0 += 8) {
        __syncthreads();
#pragma unroll
        for (int i = 0; i < 8; ++i) { const size_t r = (size_t)(b * SEQ + t0 + i) * 1024 + h * 128 + v; sq[i][v] = bf2f(QH[r]); sf[i][v] = __expf(GH[r]); }
        __syncthreads();
        for (int i = 0; i < 8; ++i) {
            const size_t r = (size_t)(b * SEQ + t0 + i) * 1024 + h * 128 + v;
            const float vi = bf2f(IH[r]); float o = 0.f;
#pragma unroll
            for (int k = 0; k < 128; ++k) { const float f = sf[i][k]; S[k] = f * S[k] + (1.f - f) * vi; o += sq[i][k] * S[k]; }
            float ss = wave_sum(o * o);
            __syncthreads();
            if ((v & 63) == 0) red[v >> 6] = ss;
            __syncthreads();
            const float tot = red[0] + red[1];
            const float go = bf2f(GO[r]);
            const float y = o * (1.f / sqrtf(tot * (1.f / 128.f) + EPS)) * gn * (go * sigmoidf_(go));
            AR[(size_t)(b * SEQ + t0 + i) * 2048 + 1024 + h * 128 + v] = f2bf(y);
        }
    }
}

struct EpMixA { bf16_t* mix; const bf16_t* sg;
    __device__ void operator()(int m, int c, float acc, float) const { const size_t i = (size_t)m * 2048 + c; mix[i] = f2bf(bf2f(sg[i]) * acc); } };
struct EpMixB { bf16_t* mix; const bf16_t* sg;
    __device__ void operator()(int m, int c, float acc, float) const { const size_t i = (size_t)m * 2048 + c; mix[i] = f2bf(bf2f(mix[i]) + bf2f(sg[i]) * acc); } };
__global__ void __launch_bounds__(256) bl_branch(Params p, int which) {
    __shared__ float As[8][132], Bs[8][132];
    const bf16_t* AR = (const bf16_t*)((unsigned char*)p.out + 64 * MiB);
    if (which == 0) { ALbf al{AR, 2048}; BLf bl{p.w_a, DM}; EpMixA ep{(bf16_t*)(p.ws + WS_MIX), (const bf16_t*)(p.ws + WS_SGA)};
        bl_gemm_tile<ALbf, BLf, EpMixA, false>(al, bl, ep, blockIdx.y * 128, blockIdx.x * 128, 1024, As, Bs, nullptr); }
    else { ALbf al{AR + 1024, 2048}; BLf bl{p.w_r, DM}; EpMixB ep{(bf16_t*)(p.ws + WS_MIX), (const bf16_t*)(p.ws + WS_SGB)};
        bl_gemm_tile<ALbf, BLf, EpMixB, false>(al, bl, ep, blockIdx.y * 128, blockIdx.x * 128, 1024, As, Bs, nullptr); }
}
struct EpRes { const float* x; float* out;
    __device__ void operator()(int m, int c, float acc, float) const { const size_t i = (size_t)m * 2048 + c; out[i] = x[i] + acc; } };
__global__ void __launch_bounds__(256) bl_g3(Params p) {
    __shared__ float As[8][132], Bs[8][132];
    ALbf al{(const bf16_t*)(p.ws + WS_MIX), 2048}; BLf bl{p.w_out, DM}; EpRes ep{p.x, p.out};
    bl_gemm_tile<ALbf, BLf, EpRes, false>(al, bl, ep, blockIdx.y * 128, blockIdx.x * 128, DM, As, Bs, nullptr);
}

__global__ void __launch_bounds__(256) bl_router(Params p) {
    const int lane = threadIdx.x & 63, gw = (blockIdx.x * 256 + threadIdx.x) >> 6, ngw = (gridDim.x * 256) >> 6;
    float* rs2 = (float*)(p.ws + WS_RS2); bf16_t* XB2 = (bf16_t*)(p.ws + WS_XB2); int* EID = (int*)(p.ws + WS_EID); float* EW = (float*)(p.ws + WS_EW);
    int* CNT = (int*)(p.ws + WS_CTL); int* LIST = (int*)(p.ws + WS_LIST);
    for (int r = gw; r < NTOK; r += ngw) {
        const float* xr = p.out + (size_t)r * DM;
        float ss = 0.f, lg[36];
#pragma unroll
        for (int e = 0; e < 36; ++e) lg[e] = 0.f;
        for (int i = 0; i < DM / 64; ++i) {
            const int k = lane + 64 * i; const float xv = xr[k]; ss += xv * xv;
            XB2[(size_t)r * DM + k] = f2bf(xv);
            const float hv = xv * p.norm2_g[k];
#pragma unroll
            for (int e = 0; e < 4; ++e) lg[e] += hv * p.w_gr[k * 4 + e];
#pragma unroll
            for (int e = 0; e < 32; ++e) lg[4 + e] += hv * p.w_er[k * 32 + e];
        }
        ss = wave_sum(ss);
#pragma unroll
        for (int e = 0; e < 36; ++e) lg[e] = wave_sum(lg[e]);
        const float rstd = 1.f / sqrtf(ss * (1.f / DM) + EPS);
        if (lane == 0) {
            rs2[r] = rstd;
            float gl[4]; int gi = 0;
#pragma unroll
            for (int e = 0; e < 4; ++e) gl[e] = lg[e] * rstd + p.b_gr[e];
            float gm = gl[0];
#pragma unroll
            for (int e = 1; e < 4; ++e) if (gl[e] > gm) { gm = gl[e]; gi = e; }
            float gs = 0.f;
#pragma unroll
            for (int e = 0; e < 4; ++e) gs += __expf(gl[e] - gm);
            const float gw_ = 1.f / gs;
            float el[8];
#pragma unroll
            for (int e = 0; e < 8; ++e) { float v = 0.f;
#pragma unroll
                for (int g = 0; g < 4; ++g) v = (g == gi) ? lg[4 + g * 8 + e] : v;
                el[e] = v * rstd + p.b_er[gi * 8 + e]; }
            int i1 = 0; float m1 = el[0];
#pragma unroll
            for (int e = 1; e < 8; ++e) if (el[e] > m1) { m1 = el[e]; i1 = e; }
            int i2 = -1; float m2 = -3.0e38f;
#pragma unroll
            for (int e = 0; e < 8; ++e) if (e != i1 && el[e] > m2) { m2 = el[e]; i2 = e; }
            const float p2 = __expf(m2 - m1);
            const float w1 = gw_ / (1.f + p2), w2 = gw_ * p2 / (1.f + p2);
            const int e1 = gi * 8 + i1, e2 = gi * 8 + i2;
            EID[2 * r] = e1; EID[2 * r + 1] = e2; EW[2 * r] = w1; EW[2 * r + 1] = w2;
            const int p1 = atomicAdd(&CNT[e1], 1); LIST[e1 * LIST_CAP + p1] = 2 * r;
            const int p2_ = atomicAdd(&CNT[e2], 1); LIST[e2 * LIST_CAP + p2_] = 2 * r + 1;
        }
    }
}

__device__ __forceinline__ bool moe_map(const int* CNT, int by, int& e, int& i0, int& cnt, int& hb0) {
    int t = by, off = 0;
    for (int ee = 0; ee < NEXP; ++ee) { const int c = CNT[ee], nt = (c + 127) >> 7; if (t < nt) { e = ee; i0 = t * 128; cnt = c; hb0 = off + i0; return true; } t -= nt; off += ((c + 255) >> 8) << 8; }
    return false;
}
struct ALmoe1 { const bf16_t* xb2; const float* rs2; const float* g2; const int* list; int i0, cnt;
    __device__ RowDesc row(int m) const { RowDesc d; const int i = i0 + m; if (i < cnt) { const int tok = list[i] >> 1; d.p = xb2 + (size_t)tok * DM; d.s = rs2[tok]; } else { d.p = xb2; d.s = 0.f; } return d; }
    __device__ float ld(const RowDesc& d, int k) const { return bf2f(((const bf16_t*)d.p)[k]) * d.s * g2[k]; } };
struct BLgu { const float* wg; const float* wu;
    __device__ float ld(int k, int n) const { return wg[(size_t)k * EFF + n]; }
    __device__ float ld2(int k, int n) const { return wu[(size_t)k * EFF + n]; } };
struct EpHB { bf16_t* hb; int hb0;
    __device__ void operator()(int m, int c, float g, float u) const { hb[(size_t)(hb0 + m) * EFF + c] = f2bf(g * sigmoidf_(g) * u); } };
__global__ void __launch_bounds__(256) bl_moe1(Params p) {
    __shared__ float As[8][132], Bs[8][132], Bs2[8][132];
    const int* CNT = (const int*)(p.ws + WS_CTL); int e, i0, cnt, hb0;
    if (!moe_map(CNT, blockIdx.y, e, i0, cnt, hb0)) return;
    ALmoe1 al{(const bf16_t*)(p.ws + WS_XB2), (const float*)(p.ws + WS_RS2), p.norm2_g, (const int*)(p.ws + WS_LIST) + e * LIST_CAP, i0, cnt};
    BLgu bl{p.w_gate + (size_t)e * DM * EFF, p.w_up + (size_t)e * DM * EFF}; EpHB ep{(bf16_t*)(p.ws + WS_HB), hb0};
    bl_gemm_tile<ALmoe1, BLgu, EpHB, true>(al, bl, ep, 0, blockIdx.x * 128, DM, As, Bs, Bs2);
}
struct EpYB { bf16_t* yb; const float* ew; const int* list; int i0, cnt;
    __device__ void operator()(int m, int c, float acc, float) const { const int i = i0 + m; if (i < cnt) { const int slot = list[i]; yb[(size_t)slot * DM + c] = f2bf(acc * ew[slot]); } } };
__global__ void __launch_bounds__(256) bl_moe2(Params p) {
    __shared__ float As[8][132], Bs[8][132];
    const int* CNT = (const int*)(p.ws + WS_CTL); int e, i0, cnt, hb0;
    if (!moe_map(CNT, blockIdx.y, e, i0, cnt, hb0)) return;
    ALbf al{(const bf16_t*)(p.ws + WS_HB) + (size_t)hb0 * EFF, EFF}; BLf bl{p.w_down + (size_t)e * EFF * DM, DM};
    EpYB ep{(bf16_t*)(p.ws + WS_YB), (const float*)(p.ws + WS_EW), (const int*)(p.ws + WS_LIST) + e * LIST_CAP, i0, cnt};
    bl_gemm_tile<ALbf, BLf, EpYB, false>(al, bl, ep, 0, blockIdx.x * 128, EFF, As, Bs, nullptr);
}

__global__ void __launch_bounds__(256) bl_final(Params p) {
    const int lane = threadIdx.x & 63, gw = (blockIdx.x * 256 + threadIdx.x) >> 6, ngw = (gridDim.x * 256) >> 6;
    const bf16_t* YB = (const bf16_t*)(p.ws + WS_YB);
    for (int r = gw; r < NTOK; r += ngw) {
        float* xr = p.out + (size_t)r * DM; float v[DM / 64]; float ss = 0.f;
#pragma unroll
        for (int i = 0; i < DM / 64; ++i) { const int k = lane + 64 * i; v[i] = xr[k] + bf2f(YB[(size_t)(2 * r) * DM + k]) + bf2f(YB[(size_t)(2 * r + 1) * DM + k]); ss += v[i] * v[i]; }
        ss = wave_sum(ss);
        const float rstd = 1.f / sqrtf(ss * (1.f / DM) + EPS);
#pragma unroll
        for (int i = 0; i < DM / 64; ++i) { const int k = lane + 64 * i; xr[k] = v[i] * rstd * p.final_g[k]; }
    }
}


#define LAS_ __attribute__((address_space(3)))
__device__ __forceinline__ unsigned pk4_fp8(float a, float b, float c, float d) { int w = 0; w = __builtin_amdgcn_cvt_pk_fp8_f32(a, b, w, false); w = __builtin_amdgcn_cvt_pk_fp8_f32(c, d, w, true); return (unsigned)w; }
typedef _Float16 h16x2 __attribute__((ext_vector_type(2)));
__device__ __forceinline__ unsigned pk2_h16(float a, float b) { h16x2 v = {(_Float16)a, (_Float16)b}; return __builtin_bit_cast(unsigned, v); }
__device__ __forceinline__ float h16_lo(unsigned w) { return (float)__builtin_bit_cast(h16x2, w).x; }
__device__ __forceinline__ float h16_hi(unsigned w) { return (float)__builtin_bit_cast(h16x2, w).y; }
constexpr float WGU_SCALE = 64.f, WDN_SCALE = 32.f, WIN8_SCALE = 64.f, YB_SCALE = 16.f;
namespace pg8 {
#define PG8_LAS __attribute__((address_space(3)))
typedef short bf16x8 __attribute__((ext_vector_type(8)));
typedef float f32x4 __attribute__((ext_vector_type(4)));
typedef unsigned u32x4 __attribute__((ext_vector_type(4)));
typedef unsigned u32x2 __attribute__((ext_vector_type(2)));
typedef int v4i __attribute__((ext_vector_type(4)));
typedef int v8i __attribute__((ext_vector_type(8)));
constexpr int KROT = 1;
constexpr int BM = 256, BK = 64, HALF = 128, HTB = HALF * BK * 2, STAGE_BYTES = 8 * HTB, NXCD = 8, WGM = 8;

__host__ __device__ __forceinline__ int lds_byte(int r, int c) { const int st = (r >> 4) * 2 + (c >> 5), rr = r & 15, cc = c & 31, ob = rr * 64 + cc * 2; return st * 1024 + (ob ^ (((ob >> 9) & 1) << 5)); }
__host__ __device__ __forceinline__ void stage_rc(int b, int& R, int& C) { const int st = b / 1024, sb = b % 1024, swz = sb ^ (((sb >> 9) & 1) << 5); R = (st >> 1) * 16 + swz / 64; C = (st & 1) * 32 + (swz % 64) / 2; }
__host__ __device__ __forceinline__ int perm32(int rho) { const int n = rho >> 4, i = rho & 15; return 8 * (i >> 2) + 4 * n + (i & 3); }

struct Unit { int pm, pn, e, i0, cnt, aux; };

struct StaticOrder {
    int nM, nN, nwg, G, c, wgm; const char* A; const char* B; size_t tstep;
    __device__ void init(int M, int N, int KBytes, int G_, int c_, const void* A_, const void* B_, int wgm_) { nM = M / BM; nN = N / BM; nwg = nM * nN; G = G_; c = c_; wgm = wgm_; A = (const char*)A_; B = (const char*)B_; tstep = (size_t)BM * KBytes; }
    __device__ __forceinline__ bool next(int i, Unit& u) const {
        const long L = (long)i * G + c; if (L >= nwg) return false;
        int wgid = (int)L; { const int q = nwg / NXCD, r = nwg % NXCD, xcd = wgid % NXCD, off = wgid / NXCD; wgid = (xcd < r ? xcd * (q + 1) : r * (q + 1) + (xcd - r) * q) + off; }
        const int nig = wgm * nN, gid = wgid / nig, fm = gid * wgm, gsz = (nM - fm) < wgm ? (nM - fm) : wgm;
        u.pm = fm + ((wgid % nig) % gsz); u.pn = (wgid % nig) / gsz; u.e = 0; u.i0 = 0; u.cnt = 0; u.aux = KROT ? gid * 4 : 0; return true;
    }
    __device__ __forceinline__ const char* Aptr(const Unit& u) const { return A + (size_t)u.pm * tstep; }
    __device__ __forceinline__ const char* Bptr(const Unit& u) const { return B + (size_t)u.pn * tstep; }
    __device__ __forceinline__ unsigned rowoff(const Unit&, int) const { return 0u; }
};

__device__ __forceinline__ unsigned cvt_pk_bf16(float lo, float hi) { unsigned r; asm volatile("v_cvt_pk_bf16_f32 %0, %1, %2" : "=v"(r) : "v"(lo), "v"(hi)); return r; }

template <class Epi, class Sched, bool ALIGN_EPI, bool GATHER, bool FP8 = false>
__device__ __forceinline__ void gemm_phase(PG8_LAS unsigned char* lds, const int K, const Sched& S, const Epi& E) {
    int tid_o = threadIdx.x; asm volatile("" : "+v"(tid_o));
    const int tid = tid_o, wid = __builtin_amdgcn_readfirstlane(tid >> 6), lane = tid & 63, wr = wid >> 2, wc = wid & 3, fr = lane & 15, fq = lane >> 4;
    int KB = FP8 ? K : 2 * K;
    asm volatile("" : "+s"(KB));
    const int nt = KB / (BK * 2);
    Unit cur, nxt; int ui = 0;
    if (!S.next(0, cur)) return;
    unsigned voffA[2][2], voffB[2];
#pragma unroll
    for (int i = 0; i < 2; ++i) { int R, C; stage_rc(tid * 16 + i * 8192, R, C); const int Rb = Epi::PERM ? ((R & ~31) + perm32(R & 31)) : R;
        voffB[i] = (unsigned)(Rb * KB + C * 2);
        if constexpr (GATHER) { voffA[0][i] = S.rowoff(cur, R) + (unsigned)C * 2u; voffA[1][i] = S.rowoff(cur, R + HALF) + (unsigned)C * 2u; }
        else { voffA[0][i] = (unsigned)(R * KB + C * 2); voffA[1][i] = voffA[0][i]; } }
    const unsigned kstep = (unsigned)(BK * 2);
    const size_t hstep = (size_t)HALF * KB;
    const size_t hstepA = GATHER ? 0 : hstep;
    const unsigned ldsw = (unsigned)wid * 1024u;
    const int aoff = lds_byte(wr * 64 + fr, fq * 8), boff = lds_byte(wc * 32 + fr, fq * 8);
#define PG8_SA(b, h) (((b) * 2 + (h)) * HTB)
#define PG8_SB(b, h) ((4 + (b) * 2 + (h)) * HTB)
#define PG8_STAGE(bufoff, gbase, voff) do { _Pragma("unroll") for (int _i = 0; _i < 2; ++_i) \
        __builtin_amdgcn_global_load_lds((const unsigned*)((const char*)(gbase) + (voff)[_i]), (PG8_LAS unsigned*)(lds + (bufoff) + ldsw + _i * 8192), 16, 0, 0); } while (0)
#define PG8_LD32(addr) __builtin_shufflevector(*(const PG8_LAS v4i*)(addr), *(const PG8_LAS v4i*)((addr) + 1024), 0, 1, 2, 3, 4, 5, 6, 7)
#define PG8_LDA(dst, b, h) do { _Pragma("unroll") for (int m = 0; m < 4; ++m) dst[m] = PG8_LD32(lds + PG8_SA(b, h) + aoff + m * 2048); } while (0)
#define PG8_LDB(dst, b, h) do { _Pragma("unroll") for (int n = 0; n < 2; ++n) dst[n] = PG8_LD32(lds + PG8_SB(b, h) + boff + n * 2048); } while (0)
#define PG8_HALF0(x) __builtin_bit_cast(bf16x8, __builtin_shufflevector((x), (x), 0, 1, 2, 3))
#define PG8_HALF1(x) __builtin_bit_cast(bf16x8, __builtin_shufflevector((x), (x), 4, 5, 6, 7))
#define PG8_MMA(ai, bj, At, Bt) do { __builtin_amdgcn_s_setprio(1); _Pragma("unroll") for (int m = 0; m < 4; ++m) _Pragma("unroll") for (int n = 0; n < 2; ++n) { \
        if constexpr (FP8) asm volatile("v_mfma_scale_f32_16x16x128_f8f6f4 %0, %1, %2, %0, %3, %3 op_sel_hi:[0,0,0]" : "+v"(acc[ai][bj][m][n]) : "v"(Bt[n]), "v"(At[m]), "v"(sc1));   \
        else { acc[ai][bj][m][n] = __builtin_amdgcn_mfma_f32_16x16x32_bf16(PG8_HALF0(Bt[n]), PG8_HALF0(At[m]), acc[ai][bj][m][n], 0, 0, 0); \
               acc[ai][bj][m][n] = __builtin_amdgcn_mfma_f32_16x16x32_bf16(PG8_HALF1(Bt[n]), PG8_HALF1(At[m]), acc[ai][bj][m][n], 0, 0, 0); } } \
        __builtin_amdgcn_s_setprio(0); } while (0)
#define PG8_WAIT_V(n) asm volatile("s_waitcnt vmcnt(" #n ")" ::: "memory")
#define PG8_WAIT_L(n) asm volatile("s_waitcnt lgkmcnt(" #n ")" ::: "memory")
#define PG8_BAR __builtin_amdgcn_s_barrier()
#define PG8_SCHED __builtin_amdgcn_sched_barrier(0)
    f32x4 acc[2][2][4][2];
#pragma unroll
    for (int a = 0; a < 2; ++a)
#pragma unroll
        for (int b = 0; b < 2; ++b)
#pragma unroll
            for (int m = 0; m < 4; ++m)
#pragma unroll
                for (int n = 0; n < 2; ++n) acc[a][b][m][n] = (f32x4){0.f, 0.f, 0.f, 0.f};
    const int sc1 = 0x7f7f7f7f;
    v8i At[4], B0[2], B1[2];
    const char* cA = S.Aptr(cur); const char* cB = S.Bptr(cur);
    PG8_LAS unsigned* prebuf = (PG8_LAS unsigned*)(lds + STAGE_BYTES);
    unsigned pnv = 0u;
    if constexpr (Epi::PRE) { const void* pa = E.pre_addr(cur, tid); asm volatile("global_load_dword %0, %1, off" : "+v"(pnv) : "v"(pa) : "memory"); }
    const unsigned k0o = (unsigned)(Epi::HAS_MID ? (cur.aux & ((nt >> 1) - 1)) : (cur.aux & (nt - 1))) * kstep, k1o = (unsigned)(Epi::HAS_MID ? ((1 + cur.aux) & ((nt >> 1) - 1)) : ((1 + cur.aux) & (nt - 1))) * kstep;
    PG8_STAGE(PG8_SB(0, 0), cB + k0o, voffB); PG8_STAGE(PG8_SB(0, 1), cB + hstep + k0o, voffB); PG8_STAGE(PG8_SA(0, 0), cA + k0o, voffA[0]); PG8_STAGE(PG8_SA(0, 1), cA + hstepA + k0o, voffA[1]);
    if (wr == 1) PG8_BAR;
    PG8_WAIT_V(2); PG8_BAR;
    PG8_STAGE(PG8_SB(1, 0), cB + k1o, voffB); PG8_STAGE(PG8_SA(1, 0), cA + k1o, voffA[0]); PG8_STAGE(PG8_SB(1, 1), cB + hstep + k1o, voffB);
    PG8_WAIT_V(6); PG8_BAR;
    for (;;) {
        const bool has_next = S.next(ui + 1, nxt);
        const char* nA = has_next ? S.Aptr(nxt) : cA; const char* nB = has_next ? S.Bptr(nxt) : cB;
        unsigned rawN[2][2] = {{0u, 0u}, {0u, 0u}};
        if constexpr (GATHER) { if (has_next) {
#pragma unroll
            for (int i = 0; i < 2; ++i) { int R, C; stage_rc(tid * 16 + i * 8192, R, C); const void* p0 = S.rowptr(nxt, R); const void* p1 = S.rowptr(nxt, R + HALF);
                asm volatile("global_load_dword %0, %1, off" : "+v"(rawN[0][i]) : "v"(p0) : "memory"); asm volatile("global_load_dword %0, %1, off" : "+v"(rawN[1][i]) : "v"(p1) : "memory"); } } }
        for (int t = 0; t < nt; t += 2) {
            if constexpr (Epi::HAS_MID) { if (t == (nt >> 1)) E.mid(acc, cur, wr, wc, fr, fq); }
            const bool last = (t == nt - 2);
#define PG8_KT(x, r0) (Epi::HAS_MID ? (((x) & (nt >> 1)) | (((x) + (r0)) & ((nt >> 1) - 1))) : (((x) + (r0)) & (nt - 1)))
            const int rc = cur.aux, rn = has_next ? nxt.aux : cur.aux;
            const char* a1 = cA + (unsigned)PG8_KT(t + 1, rc) * kstep;
            const char* a2 = last ? nA + (unsigned)PG8_KT(0, rn) * kstep : cA + (unsigned)PG8_KT(t + 2, rc) * kstep; const char* b2 = last ? nB + (unsigned)PG8_KT(0, rn) * kstep : cB + (unsigned)PG8_KT(t + 2, rc) * kstep;
            const char* a3 = last ? nA + (unsigned)PG8_KT(1, rn) * kstep : cA + (unsigned)PG8_KT(t + 3, rc) * kstep; const char* b3 = last ? nB + (unsigned)PG8_KT(1, rn) * kstep : cB + (unsigned)PG8_KT(t + 3, rc) * kstep;
            unsigned vs[2][2];
            if constexpr (GATHER) { if (last) {
#pragma unroll
                for (int i = 0; i < 2; ++i) { if (has_next) { int R_, C_; stage_rc(tid * 16 + i * 8192, R_, C_); rawN[0][i] = S.rowfix(nxt, R_, rawN[0][i]) + (unsigned)C_ * 2u; rawN[1][i] = S.rowfix(nxt, R_ + HALF, rawN[1][i]) + (unsigned)C_ * 2u; }
                    else { rawN[0][i] = voffA[0][i]; rawN[1][i] = voffA[1][i]; } } } }
#pragma unroll
            for (int i = 0; i < 2; ++i) { vs[0][i] = (GATHER && last) ? rawN[0][i] : voffA[0][i]; vs[1][i] = (GATHER && last) ? rawN[1][i] : voffA[1][i]; }
            PG8_LDB(B0, 0, 0); PG8_LDB(B1, 0, 1); PG8_SCHED; PG8_LDA(At, 0, 0); PG8_STAGE(PG8_SA(1, 1), a1 + hstepA, voffA[1]);
            PG8_WAIT_V(8); PG8_WAIT_L(0); PG8_BAR; PG8_MMA(0, 0, At, B0); PG8_MMA(0, 1, At, B1); PG8_BAR; PG8_SCHED;
            PG8_LDA(At, 0, 1); PG8_STAGE(PG8_SB(0, 0), b2, voffB); PG8_STAGE(PG8_SB(0, 1), b2 + hstep, voffB); PG8_STAGE(PG8_SA(0, 0), a2, vs[0]);
            PG8_WAIT_V(8); PG8_WAIT_L(0); PG8_BAR; PG8_MMA(1, 0, At, B0); PG8_MMA(1, 1, At, B1); PG8_BAR; PG8_SCHED;
            PG8_LDB(B0, 1, 0); PG8_LDB(B1, 1, 1); PG8_SCHED; PG8_LDA(At, 1, 0); PG8_STAGE(PG8_SA(0, 1), a2 + hstepA, vs[1]);
            PG8_WAIT_V(8); PG8_WAIT_L(0); PG8_BAR; PG8_MMA(0, 0, At, B0); PG8_MMA(0, 1, At, B1); PG8_BAR; PG8_SCHED;
            PG8_LDA(At, 1, 1); PG8_STAGE(PG8_SB(1, 0), b3, voffB); PG8_STAGE(PG8_SB(1, 1), b3 + hstep, voffB); PG8_STAGE(PG8_SA(1, 0), a3, vs[0]);
            PG8_WAIT_V(8); PG8_WAIT_L(0); PG8_BAR; PG8_MMA(1, 0, At, B0); PG8_MMA(1, 1, At, B1); PG8_BAR; PG8_SCHED;
        }
        if constexpr (ALIGN_EPI) { if (wr == 0) PG8_BAR; }
        if constexpr (FP8) asm volatile("s_nop 15\n\ts_nop 7" ::: "memory");
        if constexpr (Epi::PRE) {
            prebuf[tid] = pnv; PG8_WAIT_L(0); PG8_BAR;
            if (has_next) { const void* pa = E.pre_addr(nxt, tid); asm volatile("global_load_dword %0, %1, off" : "+v"(pnv) : "v"(pa) : "memory"); } }
        E(acc, cur, wr, wc, fr, fq, prebuf);
        if (!has_next) break;
#pragma unroll
        for (int a = 0; a < 2; ++a)
#pragma unroll
            for (int b = 0; b < 2; ++b)
#pragma unroll
                for (int m = 0; m < 4; ++m)
#pragma unroll
                    for (int n = 0; n < 2; ++n) acc[a][b][m][n] = (f32x4){0.f, 0.f, 0.f, 0.f};
        cur = nxt; cA = nA; cB = nB; ++ui;
        if constexpr (GATHER) {
#pragma unroll
            for (int i = 0; i < 2; ++i) { voffA[0][i] = rawN[0][i]; voffA[1][i] = rawN[1][i]; } }
        if constexpr (ALIGN_EPI) { if (wr == 1) PG8_BAR; }
    }
    PG8_WAIT_V(0);
    if constexpr (!ALIGN_EPI) { if (wr == 0) PG8_BAR; }
    PG8_BAR;
#undef PG8_SA
#undef PG8_SB
#undef PG8_STAGE
#undef PG8_LDA
#undef PG8_LDB
#undef PG8_MMA
#undef PG8_KT
#undef PG8_LD32
#undef PG8_HALF0
#undef PG8_HALF1
#undef PG8_WAIT_V
#undef PG8_WAIT_L
#undef PG8_BAR
#undef PG8_SCHED
}

__device__ __forceinline__ float sigm(float x) { return __builtin_amdgcn_rcpf(1.f + __expf(-x)); }

__device__ __forceinline__ u32x4 pair16(u32x2 wa, u32x2 wb, int fq) {
    const bool odd = (fq & 1) != 0; const u32x2 send = odd ? wa : wb; u32x2 recv;
    recv.x = (unsigned)__shfl_xor((int)send.x, 16); recv.y = (unsigned)__shfl_xor((int)send.y, 16);
    return odd ? (u32x4){recv.x, recv.y, wb.x, wb.y} : (u32x4){wa.x, wa.y, recv.x, recv.y};
}
struct EpiG1 {
    static constexpr bool PERM = true, HAS_MID = false, PRE = true;
    unsigned char* ws; const float* rs1; const float* lb; int pn_off; float sc_extra;
    __device__ __forceinline__ const void* pre_addr(const Unit& u, int tid) const { return rs1 + u.pm * BM + (tid & 255); }
    __device__ __forceinline__ void mid(f32x4 (&)[2][2][4][2], const Unit&, int, int, int, int) const {}
    __device__ __forceinline__ void operator()(const f32x4 (&acc)[2][2][4][2], const Unit& u, int wr, int wc, int fr, int fq, const PG8_LAS unsigned* pre) const {
        const int pn = u.pn + pn_off; int mode = 0, ld = 1024, cb = 0; size_t dst = 0; float sc = sc_extra;
        if (pn < 4) { dst = WS_QA; cb = pn * 256; sc *= 0.125f * 1.4426950408889634f; }
        else if (pn == 4) { dst = WS_KA; ld = 256; }
        else if (pn == 5) { dst = WS_VA; ld = 256; }
        else if (pn < 10) { dst = WS_QH; cb = (pn - 6) * 256; }
        else if (pn < 14) { dst = WS_GH; cb = (pn - 10) * 256; mode = 2; }
        else if (pn < 18) { dst = WS_IH; cb = (pn - 14) * 256; }
        else if (pn < 22) { dst = WS_GO; cb = (pn - 18) * 256; }
        else { mode = 3; cb = (pn - 22) * 128; ld = 2048; }
        const int row0 = u.pm * BM + wr * 64 + fr, col0 = cb + wc * 32 + 8 * fq;
        if (mode == 3) {
#pragma unroll
            for (int ai = 0; ai < 2; ++ai)
#pragma unroll
                for (int m = 0; m < 4; ++m) { const int row = row0 + ai * HALF + m * 16; const float rs = __uint_as_float(pre[wr * 64 + fr + ai * HALF + m * 16]) * sc; float ra[8], sb[8];
#pragma unroll
                    for (int n = 0; n < 2; ++n)
#pragma unroll
                        for (int j = 0; j < 4; ++j) { const float ea = __expf(-acc[ai][0][m][n][j] * rs), eb = __expf(-acc[ai][1][m][n][j] * rs);
                            const float pa = 1.f + ea, pb = 1.f + eb, t = __builtin_amdgcn_rcpf(pa * pb);
                            sb[4 * n + j] = pa * t; ra[4 * n + j] = pb * pb * t; }
                    u32x4 wr_, ws_;
#pragma unroll
                    for (int q = 0; q < 4; ++q) { wr_[q] = cvt_pk_bf16(ra[2 * q], ra[2 * q + 1]); ws_[q] = cvt_pk_bf16(sb[2 * q], sb[2 * q + 1]); }
                    __builtin_nontemporal_store(wr_, (u32x4*)((bf16_t*)(ws + WS_SGA) + (size_t)row * ld + col0)); __builtin_nontemporal_store(ws_, (u32x4*)((bf16_t*)(ws + WS_SGB) + (size_t)row * ld + col0)); }
            return; }
#pragma unroll
        for (int ai = 0; ai < 2; ++ai)
#pragma unroll
            for (int m = 0; m < 4; ++m) { const int row = row0 + ai * HALF + m * 16; const float rs = __uint_as_float(pre[wr * 64 + fr + ai * HALF + m * 16]) * sc;
#pragma unroll
                for (int bj = 0; bj < 2; ++bj) { f32x4 v0 = acc[ai][bj][m][0] * rs, v1 = acc[ai][bj][m][1] * rs; const int col = col0 + bj * HALF;
                    if (mode == 2) { const f32x4 l0 = *(const f32x4*)(lb + col), l1 = *(const f32x4*)(lb + col + 4);
#pragma unroll
                        for (int j = 0; j < 4; ++j) { v0[j] = __logf(l0[j] + (1.f - l0[j]) * sigm(v0[j])); v1[j] = __logf(l1[j] + (1.f - l1[j]) * sigm(v1[j])); }
                        u32x4 w; w.x = pk2_h16(v0[0], v0[1]); w.y = pk2_h16(v0[2], v0[3]); w.z = pk2_h16(v1[0], v1[1]); w.w = pk2_h16(v1[2], v1[3]);
                        __builtin_nontemporal_store(w, (u32x4*)((unsigned short*)(ws + dst) + (size_t)row * ld + col)); }
                    else { if (mode == 1) {
#pragma unroll
                            for (int j = 0; j < 4; ++j) { v0[j] = sigm(v0[j]); v1[j] = sigm(v1[j]); } }
                        u32x4 w; w.x = cvt_pk_bf16(v0[0], v0[1]); w.y = cvt_pk_bf16(v0[2], v0[3]); w.z = cvt_pk_bf16(v1[0], v1[1]); w.w = cvt_pk_bf16(v1[2], v1[3]);
                        __builtin_nontemporal_store(w, (u32x4*)((bf16_t*)(ws + dst) + (size_t)row * ld + col)); } } }
    }
};

struct EpiMix {
    static constexpr bool PERM = true, HAS_MID = true, PRE = false;
    const bf16_t* sga; const bf16_t* sgb; bf16_t* mix;
    __device__ __forceinline__ void mid(f32x4 (&acc)[2][2][4][2], const Unit& u, int wr, int wc, int fr, int fq) const {
        unsigned ro = (unsigned)((u.pm * BM + wr * 64 + fr) * 2048 + u.pn * BM + wc * 32 + 8 * fq) * 2u; asm volatile("" : "+v"(ro));
        u32x4 a[2][4][2];
#pragma unroll
        for (int ai = 0; ai < 2; ++ai)
#pragma unroll
            for (int m = 0; m < 4; ++m)
#pragma unroll
                for (int bj = 0; bj < 2; ++bj) a[ai][m][bj] = *(const u32x4*)((const char*)sga + ro + (ai * HALF + m * 16) * (2048 * 2) + bj * HALF * 2);
#pragma unroll
        for (int ai = 0; ai < 2; ++ai)
#pragma unroll
            for (int m = 0; m < 4; ++m)
#pragma unroll
                for (int bj = 0; bj < 2; ++bj)
#pragma unroll
                    for (int j = 0; j < 4; ++j) { const unsigned aw = a[ai][m][bj][j];
                        acc[ai][bj][m][j >> 1][(j & 1) * 2] *= __uint_as_float(aw << 16); acc[ai][bj][m][j >> 1][(j & 1) * 2 + 1] *= __uint_as_float(aw & 0xffff0000u); }
        asm volatile("" ::: "memory");
    }
    __device__ __forceinline__ void operator()(const f32x4 (&acc)[2][2][4][2], const Unit& u, int wr, int wc, int fr, int fq, const PG8_LAS unsigned* pre) const {
        const unsigned off0 = (unsigned)((u.pm * BM + wr * 64 + fr) * 2048 + u.pn * BM + wc * 32 + 8 * fq) * 2u;
#pragma unroll
        for (int ai = 0; ai < 2; ++ai) { unsigned ro = off0 + (unsigned)(ai * HALF * 2048) * 2u; asm volatile("" : "+v"(ro));
            u32x4 b[4][2];
#pragma unroll
            for (int m = 0; m < 4; ++m)
#pragma unroll
                for (int bj = 0; bj < 2; ++bj) b[m][bj] = *(const u32x4*)((const char*)sgb + ro + m * (16 * 2048 * 2) + bj * HALF * 2);
#pragma unroll
            for (int m = 0; m < 4; ++m)
#pragma unroll
                for (int bj = 0; bj < 2; ++bj) { u32x4 w;
#pragma unroll
                    for (int j = 0; j < 4; ++j) { const unsigned bw = b[m][bj][j];
                        w[j] = cvt_pk_bf16(acc[ai][bj][m][j >> 1][(j & 1) * 2] * __uint_as_float(bw << 16), acc[ai][bj][m][j >> 1][(j & 1) * 2 + 1] * __uint_as_float(bw & 0xffff0000u)); }
                    *(u32x4*)((char*)mix + ro + m * (16 * 2048 * 2) + bj * HALF * 2) = w; }
            asm volatile("" ::: "memory"); }
    }
};
struct EpiRes {
    static constexpr bool PERM = true, HAS_MID = false, PRE = false;
    const bf16_t* x; bf16_t* xb2; float* ss2p; unsigned char* xf2;
    __device__ __forceinline__ void mid(f32x4 (&)[2][2][4][2], const Unit&, int, int, int, int) const {}
    __device__ __forceinline__ void operator()(const f32x4 (&acc)[2][2][4][2], const Unit& u, int wr, int wc, int fr, int fq, const PG8_LAS unsigned* pre) const {
        const unsigned off0 = (unsigned)((u.pm * BM + wr * 64 + fr) * 2048 + u.pn * BM + wc * 32 + 8 * fq);
#pragma unroll
        for (int ai = 0; ai < 2; ++ai)
#pragma unroll
            for (int mp = 0; mp < 1; ++mp) {
                unsigned rb = off0 + (unsigned)((ai * HALF) * 2048); asm volatile("" : "+v"(rb));
                f32x4 xv[4][2][2];
#pragma unroll
                for (int mi = 0; mi < 4; ++mi)
#pragma unroll
                    for (int bj = 0; bj < 2; ++bj) { const u32x4 xw = *(const u32x4*)(x + rb + mi * (16 * 2048) + bj * HALF);
                        xv[mi][bj][0] = (f32x4){__uint_as_float(xw.x << 16), __uint_as_float(xw.x & 0xffff0000u), __uint_as_float(xw.y << 16), __uint_as_float(xw.y & 0xffff0000u)};
                        xv[mi][bj][1] = (f32x4){__uint_as_float(xw.z << 16), __uint_as_float(xw.z & 0xffff0000u), __uint_as_float(xw.w << 16), __uint_as_float(xw.w & 0xffff0000u)}; }
                u32x2 w8s[4][2];
#pragma unroll
                for (int mi = 0; mi < 4; ++mi) { const int m = mi; const unsigned ro = rb + mi * (16 * 2048); float ss = 0.f;
#pragma unroll
                    for (int bj = 0; bj < 2; ++bj) { const f32x4 v0 = xv[mi][bj][0] + acc[ai][bj][m][0], v1 = xv[mi][bj][1] + acc[ai][bj][m][1];
                        ss += (v0[0] * v0[0] + v0[1] * v0[1]) + (v0[2] * v0[2] + v0[3] * v0[3]) + (v1[0] * v1[0] + v1[1] * v1[1]) + (v1[2] * v1[2] + v1[3] * v1[3]);
                        u32x4 w; w.x = cvt_pk_bf16(v0[0], v0[1]); w.y = cvt_pk_bf16(v0[2], v0[3]); w.z = cvt_pk_bf16(v1[0], v1[1]); w.w = cvt_pk_bf16(v1[2], v1[3]);
                        *(u32x4*)(xb2 + ro + bj * HALF) = w;
                        w8s[mi][bj].x = pk4_fp8(v0[0], v0[1], v0[2], v0[3]); w8s[mi][bj].y = pk4_fp8(v1[0], v1[1], v1[2], v1[3]); }
                    ss += __shfl_xor(ss, 16); ss += __shfl_xor(ss, 32);
                    if (fq == 0) ss2p[(size_t)(u.pm * BM + wr * 64 + fr + ai * HALF + m * 16) * 32 + u.pn * 4 + wc] = ss; }
#pragma unroll
                for (int mp2 = 0; mp2 < 2; ++mp2)
#pragma unroll
                    for (int bj = 0; bj < 2; ++bj) { const u32x4 q = pair16(w8s[2 * mp2][bj], w8s[2 * mp2 + 1][bj], fq);
                        *(u32x4*)(xf2 + rb + (2 * mp2 + (fq & 1)) * (16 * 2048) + bj * HALF - 8 * (fq & 1)) = q; }
                asm volatile("" ::: "memory"); }
    }
};
__device__ __forceinline__ int expert_of_tile(const LAS_ int* tab, int T) {
    const int lane = (int)__builtin_amdgcn_mbcnt_hi(~0u, __builtin_amdgcn_mbcnt_lo(~0u, 0u));
    const int v = tab[32 + (lane & 31)];
    const unsigned long long m = __ballot(lane >= 1 && lane < NEXP && v <= T);
    return (int)__popcll(m);
}
struct MoeSched1 {
    const LAS_ int* tab; int G, c, nunits; const char* xb2; const char* wgu; const int* list;
    __device__ __forceinline__ bool next(int i, Unit& o) const {
        const int L = i * G + c; if (L >= nunits) return false;
        const int T = L >> 2; const int e = expert_of_tile(tab, T);
        o.pm = T; o.pn = L & 3; o.e = e; o.i0 = (T - tab[32 + e]) * 256; o.cnt = tab[e]; o.aux = 0; return true;
    }
    __device__ __forceinline__ const char* Aptr(const Unit&) const { return xb2; }
    __device__ __forceinline__ const char* Bptr(const Unit& q) const { return wgu + ((size_t)q.e * 1024 + (size_t)q.pn * 256) * DM; }
    __device__ __forceinline__ unsigned rowoff(const Unit& q, int r) const { const int i = q.i0 + r; const int tok = (i < q.cnt) ? (list[q.e * LIST_CAP + i] >> 1) : 0; return (unsigned)tok * (unsigned)DM; }
    __device__ __forceinline__ const void* rowptr(const Unit& q, int r) const { return list + q.e * LIST_CAP + q.i0 + r; }
    __device__ __forceinline__ unsigned rowfix(const Unit& q, int r, unsigned raw) const { return (q.i0 + r < q.cnt) ? (raw >> 1) * (unsigned)DM : 0u; }
};
struct EpiMoe1 {
    static constexpr bool PERM = true, HAS_MID = false, PRE = true;
    const int* list; const float* rs2; unsigned char* hb;
    __device__ __forceinline__ const void* pre_addr(const Unit& u, int tid) const { return rs2 + u.e * LIST_CAP + u.i0 + (tid & 255); }
    __device__ __forceinline__ void mid(f32x4 (&)[2][2][4][2], const Unit&, int, int, int, int) const {}
    __device__ __forceinline__ void operator()(const f32x4 (&acc)[2][2][4][2], const Unit& u, int wr, int wc, int fr, int fq, const PG8_LAS unsigned* pre) const {
        const int r0 = wr * 64 + fr, col0 = u.pn * 128 + wc * 32 + 8 * fq;
#pragma unroll
        for (int ai = 0; ai < 2; ++ai) { u32x2 w[4];
#pragma unroll
            for (int m = 0; m < 4; ++m) { const int r = r0 + ai * HALF + m * 16, i = u.i0 + r; float rs = 0.f;
                if (i < u.cnt) rs = __uint_as_float(pre[r]) * (1.f / WGU_SCALE);
#pragma unroll
                for (int n = 0; n < 2; ++n) { const f32x4 g = acc[ai][0][m][n] * rs, uu = acc[ai][1][m][n] * rs; f32x4 h;
#pragma unroll
                    for (int j = 0; j < 4; ++j) h[j] = g[j] * sigm(g[j]) * uu[j];
                    w[m][n] = pk4_fp8(h[0], h[1], h[2], h[3]); } }
#pragma unroll
            for (int mp = 0; mp < 2; ++mp) { const u32x4 q = pair16(w[2 * mp], w[2 * mp + 1], fq);
                const int r = r0 + ai * HALF + (2 * mp + (fq & 1)) * 16;
                *(u32x4*)(hb + (size_t)(u.pm * 256 + r) * EFF + col0 - 8 * (fq & 1)) = q; } }
    }
};
struct MoeSched2 {
    const LAS_ int* tab; int G, c, nunits; const char* hb; const char* wdn;
    __device__ __forceinline__ bool next(int i, Unit& o) const {
        const int L = i * G + c; if (L >= nunits) return false;
        const int T = L >> 3; const int e = expert_of_tile(tab, T);
        o.pm = T; o.pn = L & 7; o.e = e; o.i0 = (T - tab[32 + e]) * 256; o.cnt = tab[e]; o.aux = 0; return true;
    }
    __device__ __forceinline__ const char* Aptr(const Unit& q) const { return hb + (size_t)q.pm * 256 * EFF; }
    __device__ __forceinline__ const char* Bptr(const Unit& q) const { return wdn + ((size_t)q.e * DM + (size_t)q.pn * 256) * EFF; }
    __device__ __forceinline__ unsigned rowoff(const Unit&, int) const { return 0u; }
};
struct EpiMoe2 {
    static constexpr bool PERM = true, HAS_MID = false, PRE = true;
    __device__ __forceinline__ const void* pre_addr(const Unit& u, int tid) const { const int i = u.e * LIST_CAP + u.i0 + (tid & 255); return tid < 256 ? (const void*)(list + i) : (const void*)(ew + i); }
    const int* list; const float* ew; unsigned char* yb;
    __device__ __forceinline__ void mid(f32x4 (&)[2][2][4][2], const Unit&, int, int, int, int) const {}
    __device__ __forceinline__ void operator()(const f32x4 (&acc)[2][2][4][2], const Unit& u, int wr, int wc, int fr, int fq, const PG8_LAS unsigned* pre) const {
        const int r0 = wr * 64 + fr, col0 = u.pn * 256 + wc * 32 + 8 * fq, odd = fq & 1;
#pragma unroll
        for (int ai = 0; ai < 2; ++ai)
#pragma unroll
            for (int mp = 0; mp < 2; ++mp) {
                float wv[2]; int slot[2];
#pragma unroll
                for (int q = 0; q < 2; ++q) { const int i = u.i0 + r0 + ai * HALF + (2 * mp + q) * 16; wv[q] = 0.f; slot[q] = -1;
                    if (i < u.cnt) { slot[q] = (int)pre[i - u.i0]; wv[q] = __uint_as_float(pre[256 + i - u.i0]) * (YB_SCALE / WDN_SCALE); } }
                const int myslot = odd ? slot[1] : slot[0];
#pragma unroll
                for (int bj = 0; bj < 2; ++bj) { u32x2 w8[2];
#pragma unroll
                    for (int q = 0; q < 2; ++q) { const f32x4 v0 = acc[ai][bj][2 * mp + q][0] * wv[q], v1 = acc[ai][bj][2 * mp + q][1] * wv[q];
                        w8[q].x = pk4_fp8(v0[0], v0[1], v0[2], v0[3]); w8[q].y = pk4_fp8(v1[0], v1[1], v1[2], v1[3]); }
                    const u32x4 q16 = pair16(w8[0], w8[1], fq);
                    if (myslot >= 0) *(u32x4*)(yb + (size_t)myslot * DM + col0 - 8 * odd + bj * HALF) = q16; } }
    }
};
}

#define LAS __attribute__((address_space(3)))
#define GAS __attribute__((address_space(1)))
constexpr int NWAVES = 8;
constexpr int RING_BYTES = 131072, LDS_BYTES = 147456, MISC_OFF = LDS_BYTES - 256, TAB_OFF = LDS_BYTES - 1024;
typedef unsigned v4u __attribute__((ext_vector_type(4)));
typedef float f32x2_hw __attribute__((ext_vector_type(2))); typedef __bf16 bf16x2_hw __attribute__((ext_vector_type(2)));
__device__ __forceinline__ unsigned pk2(float lo, float hi) { f32x2_hw v = {lo, hi}; bf16x2_hw b = __builtin_convertvector(v, bf16x2_hw); return __builtin_bit_cast(unsigned, b); }
#define LDS_WAIT() asm volatile("s_waitcnt lgkmcnt(0)" ::: "memory")

struct TrItem { const float* W; const float* gain; unsigned char* WT; int ldn, ldt, kb0, row0, k0, n0, fp8; float scale; };
struct TrRegs { pg8::f32x4 v[16]; float g[16]; };
__device__ __forceinline__ void tr_load(const TrItem& d, TrRegs& R, int lane) {
    const int kr = lane >> 4, nc = (lane & 15) * 4;
#pragma unroll
    for (int i = 0; i < 16; ++i) { R.v[i] = __builtin_nontemporal_load((const pg8::f32x4*)(d.W + (size_t)(d.k0 + kr + 4 * i) * d.ldn + d.n0 + nc)); R.g[i] = d.gain ? d.gain[d.k0 + kr + 4 * i] : 1.f; }
}
__device__ __forceinline__ void tr_store(const TrItem& d, const TrRegs& R, LAS float* scr, int lane) {
    const int kr = lane >> 4, nc = (lane & 15) * 4;
#pragma unroll
    for (int i = 0; i < 16; ++i) { const float g = R.g[i] * d.scale; LAS float* q = scr + (kr + 4 * i) * 65 + nc;
        q[0] = R.v[i].x * g; q[1] = R.v[i].y * g; q[2] = R.v[i].z * g; q[3] = R.v[i].w * g; }
    LDS_WAIT(); asm volatile("" ::: "memory");
    if (d.fp8) { const int c = lane & 3, nr = lane >> 2;
#pragma unroll
        for (int j = 0; j < 4; ++j) { const int n = nr + 16 * j; const LAS float* q = scr + (16 * c) * 65 + n;
            v4u o; o.x = pk4_fp8(q[0 * 65], q[1 * 65], q[2 * 65], q[3 * 65]); o.y = pk4_fp8(q[4 * 65], q[5 * 65], q[6 * 65], q[7 * 65]);
            o.z = pk4_fp8(q[8 * 65], q[9 * 65], q[10 * 65], q[11 * 65]); o.w = pk4_fp8(q[12 * 65], q[13 * 65], q[14 * 65], q[15 * 65]);
            *(v4u*)(d.WT + (size_t)(d.row0 + n) * d.ldt + d.kb0 + 16 * c) = o; } }
    else { const int c = lane & 7, nr = lane >> 3;
#pragma unroll
        for (int j = 0; j < 8; ++j) { const int n = nr + 8 * j; const LAS float* q = scr + (8 * c) * 65 + n;
            v4u o; o.x = pk2(q[0 * 65], q[1 * 65]); o.y = pk2(q[2 * 65], q[3 * 65]); o.z = pk2(q[4 * 65], q[5 * 65]); o.w = pk2(q[6 * 65], q[7 * 65]);
            *(v4u*)(d.WT + (size_t)(d.row0 + n) * d.ldt + d.kb0 + 16 * c) = o; } }
    LDS_WAIT(); asm volatile("" ::: "memory");
}

namespace mix {
typedef float f32x16 __attribute__((ext_vector_type(16)));
typedef float f32x4 __attribute__((ext_vector_type(4)));
typedef float f32x2 __attribute__((ext_vector_type(2)));
typedef short bf16x8 __attribute__((ext_vector_type(8)));
typedef short s16x4 __attribute__((ext_vector_type(4)));
typedef unsigned u32x4 __attribute__((ext_vector_type(4)));
typedef unsigned u32x2 __attribute__((ext_vector_type(2)));
typedef __bf16 bf16x2_t __attribute__((ext_vector_type(2)));
__device__ __forceinline__ unsigned cvtpk(float lo, float hi) { f32x2 v = {lo, hi}; bf16x2_t b = __builtin_convertvector(v, bf16x2_t); return __builtin_bit_cast(unsigned, b); }
__device__ __forceinline__ int crow(int r, int h) { return (r & 3) + 8 * (r >> 2) + 4 * h; }
#define MFMA32(a, b, c) __builtin_amdgcn_mfma_f32_32x32x16_bf16((a), (b), (c), 0, 0, 0)
#define MFMA16(a, b, c) __builtin_amdgcn_mfma_f32_16x16x32_bf16((a), (b), (c), 0, 0, 0)
#define ZERO16 (f32x16){0.f, 0.f, 0.f, 0.f, 0.f, 0.f, 0.f, 0.f, 0.f, 0.f, 0.f, 0.f, 0.f, 0.f, 0.f, 0.f}

constexpr int A_KP = 72, A_VP = 260;
constexpr int A_KS = 0, A_VT = 256 * A_KP * 2, A_BIAS = A_VT + 64 * A_VP * 2, A_OST = A_BIAS + 3072;
constexpr float LOG2E = 1.4426950408889634f;
struct AttnKV { u32x4 kv[4], vv[4]; };
__device__ __forceinline__ void attn_kv_load(const Params& p, AttnKV& R, int unit, int tid) {
    const int b = unit >> 7, kvh = (unit >> 5) & 3, n = unit & 31;
    const bf16_t* KA = (const bf16_t*)(p.ws + WS_KA); const bf16_t* VA = (const bf16_t*)(p.ws + WS_VA);
    const int row = tid >> 1, half = tid & 1; const bool have = (n > 0) || (row >= 128);
    const size_t src = (size_t)(b * SEQ + (n - 1) * 128 + row) * 256 + kvh * 64 + half * 32;
#pragma unroll
    for (int c = 0; c < 4; ++c) { R.kv[c] = (u32x4){0u, 0u, 0u, 0u}; R.vv[c] = R.kv[c]; if (have) { R.kv[c] = *(const u32x4*)(KA + src + c * 8); R.vv[c] = *(const u32x4*)(VA + src + c * 8); } }
}
__device__ __forceinline__ void attn_unit(const Params& p, LAS unsigned char* lds, int unit, int next_unit, AttnKV& KV, int tid, int lane, int wave) {
    const int b = unit >> 7, kvh = (unit >> 5) & 3, n = unit & 31;
    const bf16_t* QA = (const bf16_t*)(p.ws + WS_QA);
    bf16_t* AR = (bf16_t*)((unsigned char*)p.out + 64 * MiB);
    const int g = wave >> 1, qh = wave & 1, head = kvh * 4 + g, r32 = lane & 31, h = lane >> 5;
    bf16x8 qf[4];
    { const int tok0 = b * SEQ + n * 128 + qh * 64;
#pragma unroll
      for (int ks = 0; ks < 4; ++ks) qf[ks] = *(const bf16x8*)(QA + (size_t)(tok0 + r32) * 1024 + head * 64 + 16 * ks + 8 * h); }
    __syncthreads();
    {
        const int row = tid >> 1, half = tid & 1;
#pragma unroll
        for (int c = 0; c < 4; ++c) *(LAS u32x4*)(lds + A_KS + row * (A_KP * 2) + half * 64 + c * 16) = KV.kv[c];
        LAS bf16_t* vt = (LAS bf16_t*)(lds + A_VT);
#pragma unroll
        for (int c = 0; c < 4; ++c)
#pragma unroll
            for (int e = 0; e < 4; ++e) { const unsigned w = KV.vv[c][e]; const int d = half * 32 + c * 8 + 2 * e; vt[d * A_VP + row] = (bf16_t)(w & 0xffffu); vt[(d + 1) * A_VP + row] = (bf16_t)(w >> 16); }
#pragma unroll
        for (int q = tid; q < 768; q += 512) { const int gg = q / 192, dist = q % 192 - 32;
            ((LAS float*)(lds + A_BIAS))[q] = (dist >= 0 && dist < 128) ? p.rel_bias[T5B[dist & 127] * 16 + kvh * 4 + gg] * LOG2E : -INFINITY; }
    }
    __syncthreads();
    if (next_unit >= 0) attn_kv_load(p, KV, next_unit, tid);
    const float sink = p.sinks[head] * LOG2E;
    const LAS float* bext = (const LAS float*)(lds + A_BIAS) + g * 192 + (r32 - 4 * h + 32);
#pragma unroll 1
    for (int qt = 0; qt < 2; ++qt) {
        const int i0 = qh * 64 + qt * 32, jt0 = i0 >> 5;
        const int tok0 = b * SEQ + n * 128 + i0;
        f32x16 st[5];
#pragma unroll
        for (int jt = 0; jt < 5; ++jt) {
            st[jt] = ZERO16;
#pragma unroll
            for (int ks = 0; ks < 4; ++ks) { const bf16x8 a = *(const LAS bf16x8*)(lds + A_KS + ((jt0 + jt) * 32 + r32) * (A_KP * 2) + (16 * ks + 8 * h) * 2); st[jt] = MFMA32(a, qf[ks], st[jt]); }
        }
        if (qt == 0) {
#pragma unroll
            for (int ks = 0; ks < 4; ++ks) qf[ks] = *(const bf16x8*)(QA + (size_t)(tok0 + 32 + r32) * 1024 + head * 64 + 16 * ks + 8 * h); }
        float mx = sink;
#pragma unroll
        for (int jt = 0; jt < 5; ++jt) { const bool dead = (n == 0) && (jt0 + jt < 4);
#pragma unroll
            for (int r = 0; r < 16; ++r) { const float v = dead ? -INFINITY : st[jt][r] + bext[128 - 32 * jt - (r & 3) - 8 * (r >> 2)]; st[jt][r] = v; mx = fmaxf(mx, v); } }
        mx = fmaxf(mx, __shfl_xor(mx, 32));
        float sum = 0.f;
#pragma unroll
        for (int jt = 0; jt < 5; ++jt)
#pragma unroll
            for (int r = 0; r < 16; ++r) { const float e = __builtin_amdgcn_exp2f(st[jt][r] - mx); st[jt][r] = e; sum += e; }
        sum += __shfl_xor(sum, 32);
        const float inv = __builtin_amdgcn_rcpf(sum + __builtin_amdgcn_exp2f(sink - mx));
        f32x16 o[2];
        o[0] = ZERO16; o[1] = o[0];
#pragma unroll
        for (int jt = 0; jt < 5; ++jt)
#pragma unroll
            for (int s2 = 0; s2 < 2; ++s2) {
                u32x4 pw;
#pragma unroll
                for (int q = 0; q < 4; ++q) pw[q] = cvtpk(st[jt][8 * s2 + 2 * q] * inv, st[jt][8 * s2 + 2 * q + 1] * inv);
                const bf16x8 pa = __builtin_bit_cast(bf16x8, pw);
                const int key0 = (jt0 + jt) * 32 + 16 * s2 + 4 * h;
#pragma unroll
                for (int dt = 0; dt < 2; ++dt) { const LAS unsigned char* vp = lds + A_VT + ((dt * 32 + r32) * A_VP + key0) * 2;
                    const s16x4 lo = *(const LAS s16x4*)vp, hi = *(const LAS s16x4*)(vp + 16);
                    const bf16x8 vb = __builtin_shufflevector(lo, hi, 0, 1, 2, 3, 4, 5, 6, 7);
                    o[dt] = MFMA32(pa, vb, o[dt]); }
            }
        LAS bf16_t* stg = (LAS bf16_t*)(lds + A_OST + wave * 4096);
#pragma unroll
        for (int dt = 0; dt < 2; ++dt)
#pragma unroll
            for (int r = 0; r < 16; ++r) stg[crow(r, h) * 64 + dt * 32 + r32] = (bf16_t)(cvtpk(o[dt][r], 0.f) & 0xffffu);
        LDS_WAIT(); asm volatile("" ::: "memory");
#pragma unroll
        for (int i = 0; i < 4; ++i) { const int row = i * 8 + (lane >> 3), ch = lane & 7; const u32x4 v = *(const LAS u32x4*)(stg + row * 64 + ch * 8);
            *(u32x4*)(AR + (size_t)(tok0 + row) * 2048 + head * 64 + ch * 8) = v; }
        LDS_WAIT(); asm volatile("" ::: "memory");
    }
}

constexpr int H_QP = 0, H_KP = 17408, H_OB = 0, H_KT = 34816, H_VT = 53248, H_PB = 71680, H_ST = 80896, H_SEGT = 115712, H_EBM = 119808, H_EBL = 120320, H_EBD = 120832;
constexpr int HP128 = 272, HP64 = 144, HPO = 528;
struct HgChunkRegs { unsigned g[8]; unsigned q[8]; unsigned v[8]; };

template <bool FULL>
__device__ __forceinline__ void hg_load(const Params& p, HgChunkRegs& R, int tokc, int hh, int lane, int wave) {
    const unsigned short* GH = (const unsigned short*)(p.ws + WS_GH); const bf16_t* QH = (const bf16_t*)(p.ws + WS_QH); const bf16_t* IH = (const bf16_t*)(p.ws + WS_IH);
#pragma unroll
    for (int i = 0; i < 8; ++i) { const size_t o = (size_t)(tokc + 8 * wave + i) * 1024 + hh * 128 + 2 * lane;
        R.g[i] = *(const unsigned*)(GH + o); R.v[i] = *(const unsigned*)(IH + o); if (FULL) R.q[i] = *(const unsigned*)(QH + o); else R.q[i] = 0u; }
}

template <bool FULL>
__device__ __forceinline__ void hg_chunk(const Params& p, LAS unsigned char* lds, HgChunkRegs& R, f32x16 (&S)[2], f32x2& dlog, int tokc, int tokn, int hh, int tid, int lane, int wave) {
    const int r32 = lane & 31, h = lane >> 5;
    f32x2 gg[8];
#pragma unroll
    for (int i = 0; i < 8; ++i) gg[i] = (f32x2){h16_lo(R.g[i]), h16_hi(R.g[i])};
    f32x2 c[8]; c[0] = gg[0];
#pragma unroll
    for (int i = 1; i < 8; ++i) c[i] = c[i - 1] + gg[i];
    *(LAS f32x2*)(lds + H_SEGT + wave * 512 + lane * 8) = c[7];
    __syncthreads();
    f32x2 pre = {0.f, 0.f}, bm = {0.f, 0.f}, bl = {0.f, 0.f};
#pragma unroll
    for (int w = 0; w < 8; ++w) { const f32x2 t = *(const LAS f32x2*)(lds + H_SEGT + w * 512 + lane * 8); if (w < wave) pre += t; if (w < 4) bm += t; bl += t; }
    {
        unsigned kt0[4], kt1[4], vt0[4], vt1[4];
#pragma unroll
        for (int i = 0; i < 8; ++i) {
            const f32x2 bb = c[i] + pre;
            const float e2x = __expf(bm.x - bb.x), e2y = __expf(bm.y - bb.y);
            const float kx = (1.f - __expf(gg[i].x)) * e2x, ky = (1.f - __expf(gg[i].y)) * e2y;
            const int t = 8 * wave + i;
            if (FULL) { const float e1x = __expf(bb.x - bm.x), e1y = __expf(bb.y - bm.y);
                const float qx = __uint_as_float(R.q[i] << 16) * e1x, qy = __uint_as_float(R.q[i] & 0xffff0000u) * e1y;
                *(LAS unsigned*)(lds + H_QP + t * HP128 + lane * 4) = cvtpk(qx, qy);
                *(LAS unsigned*)(lds + H_KP + t * HP128 + lane * 4) = cvtpk(kx, ky); }
            const unsigned kxb = cvtpk(kx, 0.f) & 0xffffu, kyb = cvtpk(ky, 0.f) & 0xffffu;
            const unsigned vx = R.v[i] & 0xffffu, vy = R.v[i] >> 16;
            if (i & 1) { kt0[i >> 1] |= kxb << 16; kt1[i >> 1] |= kyb << 16; vt0[i >> 1] |= vx << 16; vt1[i >> 1] |= vy << 16; }
            else { kt0[i >> 1] = kxb; kt1[i >> 1] = kyb; vt0[i >> 1] = vx; vt1[i >> 1] = vy; }
        }
        *(LAS u32x4*)(lds + H_KT + (2 * lane) * HP64 + wave * 16) = (u32x4){kt0[0], kt0[1], kt0[2], kt0[3]};
        *(LAS u32x4*)(lds + H_KT + (2 * lane + 1) * HP64 + wave * 16) = (u32x4){kt1[0], kt1[1], kt1[2], kt1[3]};
        *(LAS u32x4*)(lds + H_VT + (2 * lane) * HP64 + wave * 16) = (u32x4){vt0[0], vt0[1], vt0[2], vt0[3]};
        *(LAS u32x4*)(lds + H_VT + (2 * lane + 1) * HP64 + wave * 16) = (u32x4){vt1[0], vt1[1], vt1[2], vt1[3]};
        if (wave == 0) {
            *(LAS f32x2*)(lds + H_EBM + lane * 8) = (f32x2){__expf(bm.x), __expf(bm.y)};
            *(LAS f32x2*)(lds + H_EBL + lane * 8) = (f32x2){__expf(bl.x), __expf(bl.y)};
            *(LAS f32x2*)(lds + H_EBD + lane * 8) = (f32x2){__expf(bl.x - bm.x), __expf(bl.y - bm.y)};
            dlog += bl;
        }
    }
    __syncthreads();
    if (tokn >= 0) hg_load<FULL>(p, R, tokn, hh, lane, wave);
    const int vt = wave >> 1, ktb = 2 * (wave & 1);
    int kvec = (ktb * 32 + 4 * h) * 4; asm volatile("" : "+v"(kvec));
    f32x16 o; u32x4 g0, g1;
    if (FULL) {
        int stw = (vt * 32 + r32) * HP128 + (ktb * 32 + 4 * h) * 2; asm volatile("" : "+v"(stw));
#pragma unroll
        for (int i = 0; i < 2; ++i)
#pragma unroll
            for (int q = 0; q < 4; ++q) { const f32x4 e = *(const LAS f32x4*)(lds + H_EBM + kvec + (i * 32 + 8 * q) * 4);
                u32x2 w; w.x = cvtpk(S[i][4 * q] * e.x, S[i][4 * q + 1] * e.y); w.y = cvtpk(S[i][4 * q + 2] * e.z, S[i][4 * q + 3] * e.w);
                *(LAS u32x2*)(lds + H_ST + stw + (i * 32 + 8 * q) * 2) = w; }
        const int ti = wave >> 1, l15 = lane & 15, l4 = lane >> 4;
#pragma unroll
        for (int i = 0; i < 2; ++i) { const int si = 2 * (wave & 1) + i; f32x4 a4 = {0.f, 0.f, 0.f, 0.f};
#pragma unroll
            for (int ks = 0; ks < 4; ++ks) { const bf16x8 a = *(const LAS bf16x8*)(lds + H_QP + (16 * ti + l15) * HP128 + (32 * ks + 8 * l4) * 2);
                const bf16x8 bq = *(const LAS bf16x8*)(lds + H_KP + (16 * si + l15) * HP128 + (32 * ks + 8 * l4) * 2); a4 = MFMA16(a, bq, a4); }
            const int sidx = 16 * si + l15;
#pragma unroll
            for (int r = 0; r < 4; ++r) { const int t = 16 * ti + 4 * l4 + r; const float v = (sidx <= t) ? a4[r] : 0.f; *(LAS bf16_t*)(lds + H_PB + t * HP64 + sidx * 2) = (bf16_t)(cvtpk(v, 0.f) & 0xffffu); } }
        __syncthreads();
        const int tt = wave & 1; o = ZERO16;
        { const bf16_t* gop = (const bf16_t*)(p.ws + WS_GO) + (size_t)(tokc + (tid >> 3)) * 1024 + hh * 128 + 16 * (tid & 7); g0 = *(const u32x4*)gop; g1 = *(const u32x4*)(gop + 8); }
#pragma unroll
        for (int ks = 0; ks < 4; ++ks) { const bf16x8 a = *(const LAS bf16x8*)(lds + H_PB + (32 * tt + r32) * HP64 + (16 * ks + 8 * h) * 2);
            const bf16x8 bv = *(const LAS bf16x8*)(lds + H_VT + (32 * vt + r32) * HP64 + (16 * ks + 8 * h) * 2); o = MFMA32(a, bv, o); }
#pragma unroll
        for (int ks = 0; ks < 8; ++ks) { const bf16x8 a = *(const LAS bf16x8*)(lds + H_QP + (32 * tt + r32) * HP128 + (16 * ks + 8 * h) * 2);
            const bf16x8 bs = *(const LAS bf16x8*)(lds + H_ST + (32 * vt + r32) * HP128 + (16 * ks + 8 * h) * 2); o = MFMA32(a, bs, o); }
    }
#pragma unroll
    for (int i = 0; i < 2; ++i) { f32x16 u = ZERO16;
#pragma unroll
        for (int ks = 0; ks < 4; ++ks) { const bf16x8 a = *(const LAS bf16x8*)(lds + H_KT + ((ktb + i) * 32 + r32) * HP64 + (16 * ks + 8 * h) * 2);
            const bf16x8 bv = *(const LAS bf16x8*)(lds + H_VT + (32 * vt + r32) * HP64 + (16 * ks + 8 * h) * 2); u = MFMA32(a, bv, u); }
#pragma unroll
        for (int q = 0; q < 4; ++q) { const f32x4 el = *(const LAS f32x4*)(lds + H_EBL + kvec + (i * 32 + 8 * q) * 4), ed = *(const LAS f32x4*)(lds + H_EBD + kvec + (i * 32 + 8 * q) * 4);
#pragma unroll
            for (int j = 0; j < 4; ++j) S[i][4 * q + j] = S[i][4 * q + j] * el[j] + u[4 * q + j] * ed[j]; } }
    if (FULL) {
        __syncthreads();
        const int tt = wave & 1;
#pragma unroll
        for (int r = 0; r < 16; ++r) *(LAS float*)(lds + H_OB + (32 * tt + crow(r, h)) * HPO + (32 * vt + r32) * 4) = o[r];
        __syncthreads();
        const int t = tid >> 3, part = tid & 7; f32x4 ov[4]; float ss = 0.f;
#pragma unroll
        for (int q = 0; q < 4; ++q) { ov[q] = *(const LAS f32x4*)(lds + H_OB + t * HPO + (16 * part + 4 * q) * 4); ss += (ov[q].x * ov[q].x + ov[q].y * ov[q].y) + (ov[q].z * ov[q].z + ov[q].w * ov[q].w); }
        ss += __shfl_xor(ss, 1); ss += __shfl_xor(ss, 2); ss += __shfl_xor(ss, 4);
        const float rstd = __builtin_amdgcn_rsqf(ss * (1.f / 128.f) + EPS);
        const size_t tok = (size_t)(tokc + t);
        unsigned gw[8] = {g0.x, g0.y, g0.z, g0.w, g1.x, g1.y, g1.z, g1.w}, ow[8];
#pragma unroll
        for (int q = 0; q < 4; ++q) { const f32x4 gn = *(const f32x4*)(p.hg_norm_g + 16 * part + 4 * q);
            const unsigned ga = gw[2 * q], gb = gw[2 * q + 1];
            const float z0 = __uint_as_float(ga << 16), z1 = __uint_as_float(ga & 0xffff0000u), z2 = __uint_as_float(gb << 16), z3 = __uint_as_float(gb & 0xffff0000u);
            const float y0 = ov[q].x * rstd * gn.x * (z0 * pg8::sigm(z0)), y1 = ov[q].y * rstd * gn.y * (z1 * pg8::sigm(z1)), y2 = ov[q].z * rstd * gn.z * (z2 * pg8::sigm(z2)), y3 = ov[q].w * rstd * gn.w * (z3 * pg8::sigm(z3));
            ow[2 * q] = cvtpk(y0, y1); ow[2 * q + 1] = cvtpk(y2, y3); }
        bf16_t* AR = (bf16_t*)((unsigned char*)p.out + 64 * MiB) + tok * 2048 + 1024 + hh * 128 + 16 * part;
        *(u32x4*)AR = (u32x4){ow[0], ow[1], ow[2], ow[3]}; *(u32x4*)(AR + 8) = (u32x4){ow[4], ow[5], ow[6], ow[7]};
    }
}

constexpr int CW_CNT = 8192;
constexpr int CW_P5 = 2560;
constexpr int CW_HG = 256;
constexpr size_t WS_HD = WS_HST + 16 * MiB;
constexpr int HA_KT0 = 0, HA_VT0 = 18432, HA_BUF = 36864;
struct HgARegs { unsigned g[8]; unsigned v[8]; };
__device__ __forceinline__ void hgA_load(const Params& p, HgARegs& R, int tokc, int hh, int lane, int wave) {
    const unsigned short* GH = (const unsigned short*)(p.ws + WS_GH); const bf16_t* IH = (const bf16_t*)(p.ws + WS_IH);
    const int tg = lane >> 3, kp = lane & 7;
#pragma unroll
    for (int i = 0; i < 8; ++i) { const size_t o = (size_t)(tokc + 8 * tg + i) * 1024 + hh * 128 + 16 * wave + 2 * kp; R.g[i] = *(const unsigned*)(GH + o); R.v[i] = *(const unsigned*)(IH + o); }
}
__device__ __forceinline__ void hg_passA(const Params& p, LAS unsigned char* lds, int unit, int tid, int lane, int wave) {
    const int bh = unit >> 3, seg = unit & 7, b = bh >> 3, hh = bh & 7; const int tok0 = b * SEQ + seg * 512;
    const int r32 = lane & 31, h = lane >> 5, vt = wave >> 1, ktb = 2 * (wave & 1), tg = lane >> 3, kp = lane & 7;
    f32x16 S[2]; S[0] = ZERO16; S[1] = S[0];
    f32x2 carry = {0.f, 0.f};
    HgARegs Ra, Rb; hgA_load(p, Ra, tok0 + 64 * 7, hh, lane, wave); hgA_load(p, Rb, tok0 + 64 * 6, hh, lane, wave);
    __syncthreads();
    auto chunk = [&](HgARegs& R, const int c) {
        const int pb = (c & 1) * HA_BUF;
        f32x2 gg[8];
#pragma unroll
        for (int i = 0; i < 8; ++i) gg[i] = (f32x2){h16_lo(R.g[i]), h16_hi(R.g[i])};
        f32x2 suf[8]; suf[7] = (f32x2){0.f, 0.f};
#pragma unroll
        for (int i = 6; i >= 0; --i) suf[i] = suf[i + 1] + gg[i + 1];
        const f32x2 tot = suf[0] + gg[0];
        f32x2 x = tot;
        { f32x2 y; y.x = __shfl(x.x, lane + 8); y.y = __shfl(x.y, lane + 8); if (tg < 7) x += y; }
        { f32x2 y; y.x = __shfl(x.x, lane + 16); y.y = __shfl(x.y, lane + 16); if (tg < 6) x += y; }
        { f32x2 y; y.x = __shfl(x.x, lane + 32); y.y = __shfl(x.y, lane + 32); if (tg < 4) x += y; }
        const f32x2 gsuf = x - tot + carry;
        f32x2 ctot; ctot.x = __shfl(x.x, kp); ctot.y = __shfl(x.y, kp);
        unsigned kt0[4], kt1[4], vt0[4], vt1[4];
#pragma unroll
        for (int i = 0; i < 8; ++i) {
            const float kx = (1.f - __expf(gg[i].x)) * __expf(gsuf.x + suf[i].x), ky = (1.f - __expf(gg[i].y)) * __expf(gsuf.y + suf[i].y);
            const unsigned kxb = cvtpk(kx, 0.f) & 0xffffu, kyb = cvtpk(ky, 0.f) & 0xffffu, vx = R.v[i] & 0xffffu, vy = R.v[i] >> 16;
            if (i & 1) { kt0[i >> 1] |= kxb << 16; kt1[i >> 1] |= kyb << 16; vt0[i >> 1] |= vx << 16; vt1[i >> 1] |= vy << 16; }
            else { kt0[i >> 1] = kxb; kt1[i >> 1] = kyb; vt0[i >> 1] = vx; vt1[i >> 1] = vy; }
        }
        const int krow = 16 * wave + 2 * kp;
        *(LAS u32x4*)(lds + pb + HA_KT0 + krow * HP64 + tg * 16) = (u32x4){kt0[0], kt0[1], kt0[2], kt0[3]};
        *(LAS u32x4*)(lds + pb + HA_KT0 + (krow + 1) * HP64 + tg * 16) = (u32x4){kt1[0], kt1[1], kt1[2], kt1[3]};
        *(LAS u32x4*)(lds + pb + HA_VT0 + krow * HP64 + tg * 16) = (u32x4){vt0[0], vt0[1], vt0[2], vt0[3]};
        *(LAS u32x4*)(lds + pb + HA_VT0 + (krow + 1) * HP64 + tg * 16) = (u32x4){vt1[0], vt1[1], vt1[2], vt1[3]};
        carry += ctot;
        if (c > 1) hgA_load(p, R, tok0 + 64 * (c - 2), hh, lane, wave);
        __syncthreads();
#pragma unroll
        for (int i = 0; i < 2; ++i)
#pragma unroll
            for (int ks = 0; ks < 4; ++ks) { const bf16x8 a = *(const LAS bf16x8*)(lds + pb + HA_KT0 + ((ktb + i) * 32 + r32) * HP64 + (16 * ks + 8 * h) * 2);
                const bf16x8 bv = *(const LAS bf16x8*)(lds + pb + HA_VT0 + (32 * vt + r32) * HP64 + (16 * ks + 8 * h) * 2); S[i] = MFMA32(a, bv, S[i]); }
    };
#pragma unroll 1
    for (int c = 7; c >= 1; c -= 2) { chunk(Ra, c); chunk(Rb, c - 1); }
    float* hst = (float*)(p.ws + WS_HST) + (size_t)unit * 16384;
#pragma unroll
    for (int i = 0; i < 2; ++i)
#pragma unroll
        for (int r = 0; r < 16; ++r) hst[(wave * 32 + i * 16 + r) * 64 + lane] = S[i][r];
    if (tg == 0) *(f32x2*)((float*)(p.ws + WS_HD) + unit * 128 + 16 * wave + 2 * kp) = carry;
    asm volatile("s_waitcnt vmcnt(0)" ::: "memory");
    __syncthreads();
    if (tid == 0) { __builtin_amdgcn_fence(__ATOMIC_RELEASE, "agent"); asm volatile("s_waitcnt vmcnt(0)" ::: "memory");
        __hip_atomic_fetch_add((unsigned*)(p.ws + WS_CTL) + CW_HG + 64 * bh, 1u, __ATOMIC_RELAXED, __HIP_MEMORY_SCOPE_AGENT); }
}
__device__ __forceinline__ void hg_passC(const Params& p, LAS unsigned char* lds, int unit, int tid, int lane, int wave) {
    const int bh = unit >> 3, seg = unit & 7, b = bh >> 3, hh = bh & 7; const int tok0 = b * SEQ + seg * 512;
    const int h = lane >> 5, ktb = 2 * (wave & 1);
    int kvec = (ktb * 32 + 4 * h) * 4; asm volatile("" : "+v"(kvec));
    f32x16 S[2]; S[0] = ZERO16; S[1] = S[0];
    if (tid == 0) {
        unsigned* cw = (unsigned*)(p.ws + WS_CTL) + CW_HG + 64 * bh; unsigned sp = 0u;
        while (__hip_atomic_load(cw, __ATOMIC_RELAXED, __HIP_MEMORY_SCOPE_AGENT) < 8u) { __builtin_amdgcn_s_sleep(2); if (++sp > (1u << 22)) break; }
        __builtin_amdgcn_fence(__ATOMIC_ACQUIRE, "agent"); asm volatile("s_waitcnt vmcnt(0)" ::: "memory"); }
    __syncthreads();
    { int t3 = threadIdx.x; asm volatile("" : "+v"(t3));
      if (t3 < 128) { float a = 0.f;
        for (int i = seg - 1; i >= 0; --i) { ((LAS float*)(lds + H_ST))[i * 128 + t3] = __expf(a); a += ((const float*)(p.ws + WS_HD))[(bh * 8 + i) * 128 + t3]; } } }
    __syncthreads();
    if (seg > 0) {
        float cur[32];
        { const float* hst = (const float*)(p.ws + WS_HST) + (size_t)(bh * 8) * 16384;
#pragma unroll
          for (int r = 0; r < 32; ++r) cur[r] = hst[(wave * 32 + r) * 64 + lane]; }
#pragma unroll 1
        for (int i = 0; i < seg; ++i) {
            float nx[32];
            const float* hst = (const float*)(p.ws + WS_HST) + (size_t)(bh * 8 + ((i + 1 < seg) ? i + 1 : i)) * 16384;
#pragma unroll
            for (int r = 0; r < 32; ++r) nx[r] = hst[(wave * 32 + r) * 64 + lane];
#pragma unroll
            for (int t2 = 0; t2 < 2; ++t2)
#pragma unroll
                for (int q = 0; q < 4; ++q) { const f32x4 e = *(const LAS f32x4*)(lds + H_ST + i * 512 + kvec + (t2 * 32 + 8 * q) * 4);
#pragma unroll
                    for (int j = 0; j < 4; ++j) S[t2][4 * q + j] += e[j] * cur[t2 * 16 + 4 * q + j]; }
#pragma unroll
            for (int r = 0; r < 32; ++r) cur[r] = nx[r];
        }
    }
    HgChunkRegs R; hg_load<true>(p, R, tok0, hh, lane, wave);
    f32x2 dlog = {0.f, 0.f};
#pragma unroll 1
    for (int c = 0; c < 8; ++c) {
        hg_chunk<true>(p, lds, R, S, dlog, tok0 + 64 * c, (c < 7) ? tok0 + 64 * (c + 1) : -1, hh, tid, lane, wave);
    }
    __syncthreads();
}
}

namespace rt {
using namespace mix;
constexpr int XP = 1040;
constexpr int R_XH = 0, R_XL = 64 * XP, R_RED = 0, R_SS = 2 * 64 * XP;
__device__ __forceinline__ void router_unit(const Params& p, LAS unsigned char* lds, int unit, int tid, int lane, int wave, bool commit) {
    const int r0 = unit * 64, r32 = lane & 31, h = lane >> 5;
    const bf16_t* XB2 = (const bf16_t*)(p.ws + WS_XB2);
    const bf16_t* WRH = (const bf16_t*)(p.ws + WS_WRH); const bf16_t* WRL = (const bf16_t*)(p.ws + WS_WRL);
    const int tile = wave & 3, rtile = tile >> 1, nt = tile & 1, kh = wave >> 2;
    f32x16 acc = ZERO16;
    u32x4 xr[8];
#pragma unroll
    for (int i = 0; i < 8; ++i) xr[i] = *(const u32x4*)(XB2 + (size_t)(r0 + 8 * wave + i) * DM + 8 * lane);
    bf16x8 wh[2][4], wl[2][4];
#define RT_WLOAD(buf, it) do { _Pragma("unroll") for (int ks = 0; ks < 4; ++ks) { const size_t o = (size_t)(32 * nt + r32) * DM + 512 * ((it) >> 2) + 256 * kh + 64 * ((it) & 3) + 16 * ks + 8 * h; \
        wh[buf][ks] = *(const bf16x8*)(WRH + o); wl[buf][ks] = *(const bf16x8*)(WRL + o); } } while (0)
    RT_WLOAD(0, 0);
#define RT_MMA(buf, kg) do { _Pragma("unroll") for (int ks = 0; ks < 4; ++ks) { const int ko = (256 * kh + 64 * (kg) + 16 * ks + 8 * h) * 2; \
        const bf16x8 ah = *(const LAS bf16x8*)(lds + R_XH + (32 * rtile + r32) * XP + ko); \
        acc = MFMA32(ah, wh[buf][ks], acc); acc = MFMA32(ah, wl[buf][ks], acc); } } while (0)
#pragma unroll 1
    for (int sl = 0; sl < 4; ++sl) {
        __syncthreads();
#pragma unroll
        for (int i = 0; i < 8; ++i) *(LAS u32x4*)(lds + R_XH + (8 * wave + i) * XP + lane * 16) = xr[i];
        if (sl < 3) {
#pragma unroll
            for (int i = 0; i < 8; ++i) xr[i] = *(const u32x4*)(XB2 + (size_t)(r0 + 8 * wave + i) * DM + 512 * (sl + 1) + 8 * lane); }
        __syncthreads();
        RT_WLOAD(1, 4 * sl + 1); RT_MMA(0, 0);
        RT_WLOAD(0, 4 * sl + 2); RT_MMA(1, 1);
        RT_WLOAD(1, 4 * sl + 3); RT_MMA(0, 2);
        if (sl < 3) RT_WLOAD(0, 4 * sl + 4);
        RT_MMA(1, 3);
    }
#undef RT_MMA
#undef RT_WLOAD
    __syncthreads();
#pragma unroll
    for (int r = 0; r < 16; ++r) *(LAS float*)(lds + R_RED + ((kh * 64 + 32 * rtile + crow(r, h)) * 65 + 32 * nt + r32) * 4) = acc[r];
    __syncthreads();
    if (tid < 64) {
        const int r = r0 + tid; float ss = 0.f;
        { const f32x4* sp = (const f32x4*)((const float*)(p.ws + WS_SS2P) + (size_t)r * 32);
#pragma unroll
          for (int q = 0; q < 8; ++q) { const f32x4 t = sp[q]; ss += (t.x + t.y) + (t.z + t.w); } }
        const float rstd = 1.f / sqrtf(ss * (1.f / DM) + EPS);
        ((float*)(p.ws + WS_RS2))[r] = rstd;
        float lg[36];
#pragma unroll
        for (int e = 0; e < 36; ++e) lg[e] = *(const LAS float*)(lds + R_RED + (tid * 65 + e) * 4) + *(const LAS float*)(lds + R_RED + ((64 + tid) * 65 + e) * 4);
        float gl[4]; int gi = 0;
#pragma unroll
        for (int e = 0; e < 4; ++e) gl[e] = lg[e] * rstd + p.b_gr[e];
        float gm = gl[0];
#pragma unroll
        for (int e = 1; e < 4; ++e) if (gl[e] > gm) { gm = gl[e]; gi = e; }
        float gs = 0.f;
#pragma unroll
        for (int e = 0; e < 4; ++e) gs += __expf(gl[e] - gm);
        const float gw_ = 1.f / gs;
        float el[8];
#pragma unroll
        for (int e = 0; e < 8; ++e) { float v = 0.f;
#pragma unroll
            for (int g = 0; g < 4; ++g) v = (g == gi) ? lg[4 + g * 8 + e] : v;
            el[e] = v * rstd + p.b_er[gi * 8 + e]; }
        int i1 = 0; float m1 = el[0];
#pragma unroll
        for (int e = 1; e < 8; ++e) if (el[e] > m1) { m1 = el[e]; i1 = e; }
        int i2 = -1; float m2 = -3.0e38f;
#pragma unroll
        for (int e = 0; e < 8; ++e) if (e != i1 && el[e] > m2) { m2 = el[e]; i2 = e; }
        const float p2 = __expf(m2 - m1);
        const float w1 = gw_ / (1.f + p2), w2 = gw_ * p2 / (1.f + p2);
        const int e1 = gi * 8 + i1, e2 = gi * 8 + i2;
        int* EID = (int*)(p.ws + WS_EID); float* EW = (float*)(p.ws + WS_EW); int* CNT = (int*)(p.ws + WS_CTL); int* LIST = (int*)(p.ws + WS_LIST);
        EID[2 * r] = e1; EID[2 * r + 1] = e2; EW[2 * r] = w1; EW[2 * r + 1] = w2;
        float* LW = (float*)(p.ws + WS_LISTW); float* LR = (float*)(p.ws + WS_LISTR);
        LAS int* lcnt = (LAS int*)(lds + 36864); LAS int* gbase = lcnt + 32;
        if (tid < 32) lcnt[tid] = 0;
        asm volatile("s_waitcnt lgkmcnt(0)" ::: "memory");
        const int lr1 = __hip_atomic_fetch_add(lcnt + e1, 1, __ATOMIC_RELAXED, __HIP_MEMORY_SCOPE_WORKGROUP);
        const int lr2 = __hip_atomic_fetch_add(lcnt + e2, 1, __ATOMIC_RELAXED, __HIP_MEMORY_SCOPE_WORKGROUP);
        asm volatile("s_waitcnt lgkmcnt(0)" ::: "memory");
        if (tid < 32) { const int c = lcnt[tid]; gbase[tid] = (commit && c > 0) ? atomicAdd(&CNT[CW_CNT + 32 * tid], c) : 0; }
        asm volatile("s_waitcnt vmcnt(0) lgkmcnt(0)" ::: "memory");
        if (commit) { const int q1 = gbase[e1] + lr1; LIST[e1 * LIST_CAP + q1] = 2 * r; LW[e1 * LIST_CAP + q1] = w1; LR[e1 * LIST_CAP + q1] = rstd;
        const int q2 = gbase[e2] + lr2; LIST[e2 * LIST_CAP + q2] = 2 * r + 1; LW[e2 * LIST_CAP + q2] = w2; LR[e2 * LIST_CAP + q2] = rstd; }
    }
}
}

#define XB_TMO      128
#define XB_XCNT(j)  (256  + 64 * (j))
#define XB_XSUB(j)  (1280 + 64 * (j))
#define XB_XGEN(j)  (2304 + 64 * (j))
#define XB_TOP      3328
#define XB_TOPGEN   3392
#define XCD_BAR_WORDS 3456
#define XB_SPIN_CAP (1u << 22)
__device__ __forceinline__ unsigned xb_ld(unsigned* p)              { return __hip_atomic_load(p, __ATOMIC_RELAXED, __HIP_MEMORY_SCOPE_AGENT); }
__device__ __forceinline__ unsigned xb_add(unsigned* p, unsigned v) { return __hip_atomic_fetch_add(p, v, __ATOMIC_RELAXED, __HIP_MEMORY_SCOPE_AGENT); }
__device__ __forceinline__ unsigned xb_xcc_id() { return (unsigned)__builtin_amdgcn_s_getreg((3 << 11) | 20) & 0xFu; }
#define XB_SPIN(cond, bar) do { unsigned _sp = 0; while (cond) { __builtin_amdgcn_s_sleep(1); \
    if ((++_sp & 255u) == 0u) { if (xb_ld(&(bar)[XB_TMO])) break; if (_sp > XB_SPIN_CAP) { atomicAdd(&(bar)[XB_TMO], 1u); break; } } } } while (0)
struct XcdBarrier { unsigned* bar; unsigned x; volatile LAS unsigned* st; };
__device__ __forceinline__ XcdBarrier xcd_barrier_post(unsigned* bar, volatile LAS unsigned* st) {
    XcdBarrier b; b.bar = bar; b.x = xb_xcc_id(); b.st = st;
    if (threadIdx.x == 0) (void)xb_add(&bar[XB_XCNT(b.x)], 1u);
    return b;
}
__device__ __forceinline__ void xcd_barrier_complete(unsigned* bar, unsigned x, unsigned& nloc, unsigned& nx) {
    const unsigned G = gridDim.x * gridDim.y * gridDim.z;
    unsigned sum, cnt, mine, sp = 0u;
    for (;;) {
        sum = 0u; cnt = 0u; mine = 0u;
#pragma unroll
        for (unsigned j = 0; j < 16; ++j) { const unsigned c = xb_ld(&bar[XB_XCNT(j)]); sum += c; cnt += (c > 0u) ? 1u : 0u; mine = (j == x) ? c : mine; }
        if (sum == G) break;
        __builtin_amdgcn_s_sleep(1);
        if ((++sp & 255u) == 0u) { if (xb_ld(&bar[XB_TMO])) break; if (sp > XB_SPIN_CAP) { atomicAdd(&bar[XB_TMO], 1u); break; } }
    }
    nloc = mine > 0u ? mine : 1u; nx = cnt > 0u ? cnt : 1u;
}
__device__ __forceinline__ void xcd_barrier(const XcdBarrier& b) {
    asm volatile("s_waitcnt vmcnt(0)" ::: "memory");
    __syncthreads();
    if (threadIdx.x == 0) {
        unsigned* bar = b.bar;
        __builtin_amdgcn_s_waitcnt(0);
        unsigned nloc = b.st[0], nx = b.st[1];
        if (nloc == 0u) { xcd_barrier_complete(bar, b.x, nloc, nx); b.st[0] = nloc; b.st[1] = nx; }
        const unsigned old = xb_add(&bar[XB_XSUB(b.x)], 1u);
        const unsigned gen = old / nloc;
        if (old + 1u == (gen + 1u) * nloc) {
            __builtin_amdgcn_fence(__ATOMIC_RELEASE, "agent");
            asm volatile("s_waitcnt vmcnt(0)" ::: "memory");
            const unsigned og = xb_add(&bar[XB_TOP], 1u);
            const unsigned tg = og / nx;
            if (og + 1u == (tg + 1u) * nx) xb_add(&bar[XB_TOPGEN], 1u);
            else XB_SPIN(xb_ld(&bar[XB_TOPGEN]) == tg, bar);
            __builtin_amdgcn_fence(__ATOMIC_ACQUIRE, "agent");
            xb_add(&bar[XB_XGEN(b.x)], 1u);
            asm volatile("s_waitcnt vmcnt(0)" ::: "memory");
        } else {
            XB_SPIN(xb_ld(&bar[XB_XGEN(b.x)]) == gen, bar);
            __builtin_amdgcn_fence(__ATOMIC_ACQUIRE, "agent");
            asm volatile("s_waitcnt vmcnt(0)" ::: "memory");
        }
    }
    __syncthreads();
}
constexpr int CW_BAR = 4096;

constexpr int WGM_G1 = 4, WGM_G18 = 4, WGM_P4 = 8, WGM_P5 = 8;
constexpr int REP_MASK = 0;
#define REPEAT(k) for (int rep_ = 0; rep_ <= ((REP_MASK >> (k)) & 1); ++rep_)
struct MKArgs { Params p; int ph_lo, ph_hi; };

constexpr int CW_Q0 = 64, CW_Q1 = 128;
__device__ __forceinline__ void q_decode(const Params& p, int kind, int r, TrItem& d) {
    if (kind == 0) { const int e = r >> 9; r &= 511; const int up = r >> 8; r &= 255; const int kb = r >> 3, n0 = 64 * (r & 7);
        d.W = (up ? p.w_up : p.w_gate) + (size_t)e * DM * EFF; d.gain = p.norm2_g; d.WT = p.ws + WS_WGU + (size_t)e * 1024 * DM; d.ldn = EFF; d.ldt = DM; d.kb0 = 64 * kb;
        d.row0 = (n0 >> 7) * 256 + up * 128 + (n0 & 127); d.k0 = 64 * kb; d.n0 = n0; d.fp8 = 1; d.scale = WGU_SCALE; }
    else { const int e = r >> 8; r &= 255; const int kb = r >> 5, n0 = 64 * (r & 31);
        d.W = p.w_down + (size_t)e * EFF * DM; d.gain = nullptr; d.WT = p.ws + WS_WDN + (size_t)e * DM * EFF; d.ldn = DM; d.ldt = EFF; d.kb0 = 64 * kb;
        d.row0 = n0; d.k0 = 64 * kb; d.n0 = n0; d.fp8 = 1; d.scale = WDN_SCALE; }
}
__device__ __forceinline__ void conv_queue(const Params& p, LAS unsigned char* lds, int kind) {
    int tid = threadIdx.x; asm volatile("" : "+v"(tid)); const int lane = tid & 63, wave = __builtin_amdgcn_readfirstlane(tid >> 6);
    unsigned* qctr = (unsigned*)(p.ws + WS_CTL) + (kind ? CW_Q1 : CW_Q0);
    volatile LAS unsigned* slot = (volatile LAS unsigned*)(lds + MISC_OFF) + 16;
    LAS float* scr = (LAS float*)(lds + wave * 16640);
    const int nitems = kind ? NEXP * 256 : NEXP * 512;
#define Q_GRAB(dst) do { __syncthreads(); if (tid == 0) *slot = atomicAdd(qctr, 8u); __syncthreads(); dst = (int)*slot; } while (0)
    int base; Q_GRAB(base);
    TrItem d0; TrRegs r0; bool v0 = (base + wave < nitems);
    if (v0) { q_decode(p, kind, base + wave, d0); tr_load(d0, r0, lane); }
    while (base < nitems) {
        int nb; Q_GRAB(nb);
        TrItem d1; TrRegs r1; const bool v1 = (nb + wave < nitems);
        if (v1) { q_decode(p, kind, nb + wave, d1); tr_load(d1, r1, lane); }
        if (v0) tr_store(d0, r0, scr, lane);
        d0 = d1; r0 = r1; v0 = v1; base = nb;
    }
    __syncthreads();
#undef Q_GRAB
}

__device__ __forceinline__ void p0_decode(const Params& p, int r, TrItem& d) {
    constexpr int I_IN = 32 * (5632 / 64), I_IN8 = 32 * (4096 / 64), I_A = 16 * 32, I_R = 16 * 32;
    unsigned char* ws = p.ws; d.fp8 = 0; d.scale = 1.f; d.gain = nullptr;
    if (r < I_IN) { const int nb = 5632 / 64, kb = r / nb, n0 = 64 * (r % nb); d.W = p.w_in; d.gain = p.norm1_g; d.WT = ws + WS_WIN; d.ldn = INW; d.ldt = DM * 2; d.kb0 = 128 * kb; d.row0 = n0; d.k0 = 64 * kb; d.n0 = n0; return; } r -= I_IN;
    if (r < I_IN8) { const int kb = r / 64, n0 = 64 * (r % 64), sec = n0 >> 11, j0 = n0 & 2047;
        d.W = p.w_in + 5632; d.gain = p.norm1_g; d.WT = ws + WS_WIN8; d.ldn = INW; d.ldt = DM; d.kb0 = 64 * kb; d.row0 = (j0 >> 7) * 256 + sec * 128 + (j0 & 127); d.k0 = 64 * kb; d.n0 = n0; d.fp8 = 1; d.scale = WIN8_SCALE; return; } r -= I_IN8;
    if (r < I_A) { const int kb = r / 32, n0 = 64 * (r % 32); d.W = p.w_a; d.WT = ws + WS_WAR; d.ldn = DM; d.ldt = 4096; d.kb0 = 128 * kb; d.row0 = n0; d.k0 = 64 * kb; d.n0 = n0; return; } r -= I_A;
    if (r < I_R) { const int kb = r / 32, n0 = 64 * (r % 32); d.W = p.w_r; d.WT = ws + WS_WAR; d.ldn = DM; d.ldt = 4096; d.kb0 = 2048 + 128 * kb; d.row0 = n0; d.k0 = 64 * kb; d.n0 = n0; return; } r -= I_R;
    { const int kb = r / 32, n0 = 64 * (r % 32); d.W = p.w_out; d.WT = ws + WS_WOUT; d.ldn = DM; d.ldt = DM * 2; d.kb0 = 128 * kb; d.row0 = n0; d.k0 = 64 * kb; d.n0 = n0; }
}

__device__ __forceinline__ void p0_prologue(const Params& p, LAS unsigned char* lds, int gw, int NGW, int wave, int lane) {
    LAS float* scr = (LAS float*)(lds + wave * 16640);
    unsigned char* ws = p.ws;
    constexpr int NITEMS = 32 * (5632 / 64) + 32 * (4096 / 64) + 16 * 32 + 16 * 32 + 32 * 32;
    { int it = gw; bool have = it < NITEMS; TrItem d0; TrRegs r0;
      if (have) { p0_decode(p, it, d0); tr_load(d0, r0, lane); }
      while (have) { const int itn = it + NGW; const bool hn = itn < NITEMS; TrItem d1; TrRegs r1;
          if (hn) { p0_decode(p, itn, d1); tr_load(d1, r1, lane); }
          tr_store(d0, r0, scr, lane);
          d0 = d1; r0 = r1; it = itn; have = hn; } }
    float* rs1 = (float*)(ws + WS_RS1); bf16_t* XB = (bf16_t*)p.out;
    { int m = gw; pg8::f32x4 v[8];
      if (m < NTOK) { const pg8::f32x4* xr = (const pg8::f32x4*)(p.x + (size_t)m * DM) + 2 * lane;
#pragma unroll
          for (int j = 0; j < 8; ++j) v[j] = __builtin_nontemporal_load(xr + 128 * (j >> 1) + (j & 1)); }
      while (m < NTOK) {
        const int mn = m + NGW; pg8::f32x4 vn[8];
        if (mn < NTOK) { const pg8::f32x4* xr = (const pg8::f32x4*)(p.x + (size_t)mn * DM) + 2 * lane;
#pragma unroll
            for (int j = 0; j < 8; ++j) vn[j] = __builtin_nontemporal_load(xr + 128 * (j >> 1) + (j & 1)); }
        float s = 0.f;
#pragma unroll
        for (int j = 0; j < 8; ++j) s += (v[j].x * v[j].x + v[j].y * v[j].y) + (v[j].z * v[j].z + v[j].w * v[j].w);
        s = wave_sum(s);
        if (lane == 0) rs1[m] = 1.f / sqrtf(s * (1.f / DM) + EPS);
        v4u* o16 = (v4u*)(XB + (size_t)m * DM) + lane;
#pragma unroll
        for (int j = 0; j < 4; ++j) { v4u o; o.x = pk2(v[2 * j].x, v[2 * j].y); o.y = pk2(v[2 * j].z, v[2 * j].w); o.z = pk2(v[2 * j + 1].x, v[2 * j + 1].y); o.w = pk2(v[2 * j + 1].z, v[2 * j + 1].w); o16[64 * j] = o; }
        pg8::u32x2* o8 = (pg8::u32x2*)((unsigned char*)p.out + 64 * MiB + (size_t)m * DM) + lane;
#pragma unroll
        for (int j = 0; j < 4; ++j) { pg8::u32x2 o; o.x = pk4_fp8(v[2 * j].x, v[2 * j].y, v[2 * j].z, v[2 * j].w); o.y = pk4_fp8(v[2 * j + 1].x, v[2 * j + 1].y, v[2 * j + 1].z, v[2 * j + 1].w); o8[64 * j] = o; }
#pragma unroll
        for (int j = 0; j < 8; ++j) v[j] = vn[j];
        m = mn;
      } }
    {
        for (int idx = gw * 64 + lane; idx < 64 * DM; idx += NGW * 64) { const int n = idx >> 11, k = idx & 2047; float w = 0.f;
            if (n < 4) w = p.w_gr[k * 4 + n]; else if (n < 36) w = p.w_er[k * 32 + n - 4];
            w *= p.norm2_g[k]; const bf16_t hi = f2bf(w); const bf16_t lo = f2bf(w - bf2f(hi));
            ((bf16_t*)(ws + WS_WRH))[idx] = hi; ((bf16_t*)(ws + WS_WRL))[idx] = lo; }
    }
    if (gw == 0) { float* lb = (float*)(ws + WS_LB); for (int j = lane; j < HKW; j += 64) { const float l0 = p.lb_logits[j], l1 = p.lb_logits[HKW + j]; lb[j] = 1.f / (1.f + __expf(l1 - l0)); } }
}

__global__ void __launch_bounds__(NWAVES * 64, 2) mk_fwd(MKArgs args) {
    extern __shared__ __attribute__((aligned(16))) unsigned char lds_raw[];
    LAS unsigned char* lds = (LAS unsigned char*)lds_raw;
    const Params& p = args.p;
    const int G = gridDim.x; const int bx = blockIdx.x; const int vcu = (G % 8 == 0) ? (bx % 8) * (G / 8) + bx / 8 : bx;
    const int NGW = G * NWAVES;
    const int lo = args.ph_lo, hi = args.ph_hi;
    const bool fused = (hi - lo) > 1;
    { volatile LAS unsigned* misc = (volatile LAS unsigned*)(lds + MISC_OFF); if (threadIdx.x < 32) misc[threadIdx.x] = 0u; }
    __syncthreads();
    XcdBarrier gbar; gbar.bar = (unsigned*)(p.ws + WS_CTL) + CW_BAR; gbar.x = 0; gbar.st = (volatile LAS unsigned*)(lds + MISC_OFF) + 8;
    if (fused) gbar = xcd_barrier_post((unsigned*)(p.ws + WS_CTL) + CW_BAR, (volatile LAS unsigned*)(lds + MISC_OFF) + 8);
#define SEAM(k) do { if (IN(k) && IN((k) + 1)) { xcd_barrier(gbar); if (REP_MASK & 1024) xcd_barrier(gbar); } } while (0)
#define IN(k) (lo <= (k) && (k) < hi)
#define OPAQUE_TID() int tid2 = threadIdx.x; asm volatile("" : "+v"(tid2)); const int lane2 = tid2 & 63, wave2 = __builtin_amdgcn_readfirstlane(tid2 >> 6)
    REPEAT(0) if (IN(0)) { OPAQUE_TID(); p0_prologue(p, lds, vcu * NWAVES + wave2, NGW, wave2, lane2); }
    SEAM(0);
    REPEAT(1) if (IN(1)) {
        pg8::StaticOrder S; S.init(NTOK, 5632, DM * 2, G, bx, p.out, p.ws + WS_WIN, WGM_G1);
        pg8::EpiG1 E{p.ws, (const float*)(p.ws + WS_RS1), (const float*)(p.ws + WS_LB), 0, 1.f};
        pg8::gemm_phase<pg8::EpiG1, pg8::StaticOrder, true, false>(lds, DM, S, E);
        {
            pg8::StaticOrder S8; S8.init(NTOK, 4096, DM, G, bx, (const unsigned char*)p.out + 64 * MiB, p.ws + WS_WIN8, WGM_G18);
            pg8::EpiG1 E8{p.ws, (const float*)(p.ws + WS_RS1), (const float*)(p.ws + WS_LB), 22, 1.f / WIN8_SCALE};
            pg8::gemm_phase<pg8::EpiG1, pg8::StaticOrder, true, false, true>(lds, DM, S8, E8);
        }
        if (rep_ == 0) conv_queue(p, lds, 0);
    }
    SEAM(1);
    REPEAT(2) if (IN(2)) {
        for (int r2 = 0; r2 <= ((REP_MASK >> 12) & 1); ++r2) { OPAQUE_TID(); for (int u = vcu; u < 256; u += G) mix::hg_passA(p, lds, u, tid2, lane2, wave2); }
        for (int r2 = 0; r2 <= ((REP_MASK >> 11) & 1); ++r2) { OPAQUE_TID(); mix::AttnKV KV; if (vcu < 512) mix::attn_kv_load(p, KV, vcu, tid2); for (int u = vcu; u < 512; u += G) mix::attn_unit(p, lds, u, (u + G < 512) ? u + G : -1, KV, tid2, lane2, wave2); }
    }
    if (G != 256) SEAM(2);
    REPEAT(3) if (IN(3)) { for (int u = vcu; u < 256; u += G) { OPAQUE_TID(); mix::hg_passC(p, lds, u, tid2, lane2, wave2); } }
    SEAM(3);
    REPEAT(4) if (IN(4)) {
        pg8::StaticOrder S; S.init(NTOK, DM, DM * 2, G, bx, (const unsigned char*)p.out + 64 * MiB, p.ws + WS_WAR, WGM_P4);
        pg8::EpiMix E{(const bf16_t*)(p.ws + WS_SGA), (const bf16_t*)(p.ws + WS_SGB), (bf16_t*)(p.ws + WS_MIX)};
        pg8::gemm_phase<pg8::EpiMix, pg8::StaticOrder, true, false>(lds, DM, S, E);
    }
    SEAM(4);
    REPEAT(5) if (IN(5)) {
        pg8::StaticOrder S; S.init(NTOK, DM, DM * 2, G, bx, p.ws + WS_MIX, p.ws + WS_WOUT, WGM_P5);
        pg8::EpiRes E{(const bf16_t*)p.out, (bf16_t*)(p.ws + WS_XB2), (float*)(p.ws + WS_SS2P), p.ws + WS_XF2};
        int pm0 = -1, pm1 = -1; { pg8::Unit u0; if (S.next(0, u0)) pm0 = u0.pm; if (S.next(1, u0)) pm1 = u0.pm; }
        pg8::gemm_phase<pg8::EpiRes, pg8::StaticOrder, true, false>(lds, DM, S, E);
        if (G == 256 && rep_ == 0) {
            asm volatile("s_waitcnt vmcnt(0)" ::: "memory");
            __syncthreads();
            if (threadIdx.x == 0) { __builtin_amdgcn_fence(__ATOMIC_RELEASE, "agent"); asm volatile("s_waitcnt vmcnt(0)" ::: "memory");
                if (pm0 >= 0) __hip_atomic_fetch_add((unsigned*)(p.ws + WS_CTL) + mix::CW_P5 + 16 * pm0, 1u, __ATOMIC_RELAXED, __HIP_MEMORY_SCOPE_AGENT);
                if (pm1 >= 0) __hip_atomic_fetch_add((unsigned*)(p.ws + WS_CTL) + mix::CW_P5 + 16 * pm1, 1u, __ATOMIC_RELAXED, __HIP_MEMORY_SCOPE_AGENT); }
        }
    }
    if (G != 256) SEAM(5);
    REPEAT(6) if (IN(6)) { OPAQUE_TID();
        for (int u = vcu; u < NTOK / 64; u += G) {
            if (G == 256) {
                if (tid2 == 0) { unsigned* cw = (unsigned*)(p.ws + WS_CTL) + mix::CW_P5 + 16 * (u >> 2); unsigned sp = 0u;
                    while (__hip_atomic_load(cw, __ATOMIC_RELAXED, __HIP_MEMORY_SCOPE_AGENT) < 8u) { __builtin_amdgcn_s_sleep(2); if (++sp > (1u << 22)) break; }
                    __builtin_amdgcn_fence(__ATOMIC_ACQUIRE, "agent"); asm volatile("s_waitcnt vmcnt(0)" ::: "memory"); }
                __syncthreads(); }
            rt::router_unit(p, lds, u, tid2, lane2, wave2, rep_ == ((REP_MASK >> 6) & 1)); } }
    SEAM(6);
    if (IN(7) || IN(8)) {
        LAS int* tab = (LAS int*)(lds + TAB_OFF);
        OPAQUE_TID();
        if (tid2 < 64) {
            const int cnt = (tid2 < 32) ? ((const int*)(p.ws + WS_CTL))[mix::CW_CNT + 32 * tid2] : 0; const int n = (cnt + 255) >> 8; int incl = n;
#pragma unroll
            for (int d = 1; d < 32; d <<= 1) { const int y = __shfl_up(incl, d); if (tid2 >= d) incl += y; }
            if (tid2 < 32) { tab[tid2] = cnt; tab[32 + tid2] = incl - n; }
            if (tid2 == 31) tab[64] = incl; }
        __syncthreads();
    }
    REPEAT(7) if (IN(7)) {
        const LAS int* tab = (const LAS int*)(lds + TAB_OFF);
        pg8::MoeSched1 S; S.tab = tab; S.G = G; S.c = bx; S.nunits = tab[64] * 4; S.xb2 = (const char*)(p.ws + WS_XF2); S.wgu = (const char*)(p.ws + WS_WGU); S.list = (const int*)(p.ws + WS_LIST);
        pg8::EpiMoe1 E{(const int*)(p.ws + WS_LIST), (const float*)(p.ws + WS_LISTR), p.ws + WS_HB};
        pg8::gemm_phase<pg8::EpiMoe1, pg8::MoeSched1, true, true, true>(lds, DM, S, E);
        if (rep_ == 0) conv_queue(p, lds, 1);
    }
    SEAM(7);
    REPEAT(8) if (IN(8)) {
        const LAS int* tab = (const LAS int*)(lds + TAB_OFF);
        pg8::MoeSched2 S; S.tab = tab; S.G = G; S.c = bx; S.nunits = tab[64] * 8; S.hb = (const char*)(p.ws + WS_HB); S.wdn = (const char*)(p.ws + WS_WDN);
        pg8::EpiMoe2 E{(const int*)(p.ws + WS_LIST), (const float*)(p.ws + WS_LISTW), p.ws + WS_YB};
        pg8::gemm_phase<pg8::EpiMoe2, pg8::MoeSched2, true, false, true>(lds, EFF, S, E);
    }
    SEAM(8);
    REPEAT(9) if (IN(9)) {
        OPAQUE_TID(); const int lane = lane2, gw = vcu * NWAVES + wave2;
        const unsigned char* YB = p.ws + WS_YB;
        struct RowRegs { pg8::u32x2 x[8]; unsigned a[8], b[8]; };
        auto load_row = [&](int m, RowRegs& R) {
            const pg8::u32x2* xb = (const pg8::u32x2*)((const bf16_t*)(p.ws + WS_XB2) + (size_t)m * DM) + lane;
            const unsigned* y0 = (const unsigned*)(YB + (size_t)(2 * m) * DM) + lane; const unsigned* y1 = (const unsigned*)(YB + (size_t)(2 * m + 1) * DM) + lane;
#pragma unroll
            for (int j = 0; j < 8; ++j) { R.x[j] = __builtin_nontemporal_load(xb + 64 * j); R.a[j] = __builtin_nontemporal_load(y0 + 64 * j); R.b[j] = __builtin_nontemporal_load(y1 + 64 * j); } };
        pg8::f32x4 gfv[8];
        { const pg8::f32x4* gf = (const pg8::f32x4*)p.final_g + lane;
#pragma unroll
          for (int j = 0; j < 8; ++j) gfv[j] = gf[64 * j]; }
        int m = gw; RowRegs R0; if (m < NTOK) load_row(m, R0);
        while (m < NTOK) {
            const int mn = m + NGW; RowRegs R1; if (mn < NTOK) load_row(mn, R1);
            pg8::f32x4* xr = (pg8::f32x4*)(p.out + (size_t)m * DM) + lane; pg8::f32x4 v[8]; float s = 0.f;
#pragma unroll
            for (int j = 0; j < 8; ++j) { const pg8::u32x2 xw = R0.x[j]; const int a = (int)R0.a[j], b = (int)R0.b[j]; constexpr float ys = 1.f / YB_SCALE;
                v[j].x = __uint_as_float(xw.x << 16) + (__builtin_amdgcn_cvt_f32_fp8(a, 0) + __builtin_amdgcn_cvt_f32_fp8(b, 0)) * ys; v[j].y = __uint_as_float(xw.x & 0xffff0000u) + (__builtin_amdgcn_cvt_f32_fp8(a, 1) + __builtin_amdgcn_cvt_f32_fp8(b, 1)) * ys;
                v[j].z = __uint_as_float(xw.y << 16) + (__builtin_amdgcn_cvt_f32_fp8(a, 2) + __builtin_amdgcn_cvt_f32_fp8(b, 2)) * ys; v[j].w = __uint_as_float(xw.y & 0xffff0000u) + (__builtin_amdgcn_cvt_f32_fp8(a, 3) + __builtin_amdgcn_cvt_f32_fp8(b, 3)) * ys;
                s += (v[j].x * v[j].x + v[j].y * v[j].y) + (v[j].z * v[j].z + v[j].w * v[j].w); }
            s = wave_sum(s);
            const float rstd = 1.f / sqrtf(s * (1.f / DM) + EPS);
#pragma unroll
            for (int j = 0; j < 8; ++j) __builtin_nontemporal_store(v[j] * rstd * gfv[j], xr + 64 * j);
            R0 = R1; m = mn;
        }
    }
#undef IN
}

extern "C" void kernel_launch(void* const* d_in, const int* in_sizes, int n_in, void* d_out, int out_size, void* d_ws, size_t ws_size, hipStream_t stream) {
    if (n_in != 19 || out_size != NTOK * DM || ws_size < WS_END) { fprintf(stderr, "kernel_launch: unexpected sizes n_in=%d out=%d ws=%zu\n", n_in, out_size, ws_size); return; }
    static int grid = 0;
    if (grid == 0) {
        int dev = 0, cus = 0, per_cu = 0;
        hipGetDevice(&dev); hipDeviceGetAttribute(&cus, hipDeviceAttributeMultiprocessorCount, dev);
        hipFuncSetAttribute((const void*)mk_fwd, hipFuncAttributeMaxDynamicSharedMemorySize, LDS_BYTES);
        hipOccupancyMaxActiveBlocksPerMultiprocessor(&per_cu, (const void*)mk_fwd, NWAVES * 64, LDS_BYTES);
        (void)hipGetLastError();
        if (per_cu < 1) per_cu = 1;
        grid = cus * per_cu;
        fprintf(stderr, "kernel_launch: cus=%d per_cu=%d grid=%d\n", cus, per_cu, grid);
    }
    Params p{};
    const float** pp = (const float**)&p;
    for (int i = 0; i < 19; ++i) pp[i] = (const float*)d_in[i];
    p.out = (float*)d_out; p.ws = (unsigned char*)d_ws;
    hipMemsetAsync((char*)d_ws + WS_CTL, 0, 40960, stream);
    MKArgs a{}; a.p = p;
    a.ph_lo = 0; a.ph_hi = 10;
    void* kargs[] = {&a};
    hipError_t e = hipLaunchCooperativeKernel((const void*)mk_fwd, dim3(grid), dim3(NWAVES * 64), kargs, LDS_BYTES, stream);
    if (e != hipSuccess) fprintf(stderr, "cooperative launch failed: %s (grid %d)\n", hipGetErrorString(e), grid);
}
```

```cpp
#include <hip/hip_runtime.h>
#include <stdint.h>
#include <cstdio>

constexpr int NTOK = 16384, DM = 2048, SEQ = 4096, NB = 4;
constexpr int INW = 9728;
__host__ __device__ constexpr int g1_code_bf16(int t) { return 6 + t; }
__host__ __device__ constexpr int g1_code_fp8(int t) { return t < 6 ? t : 16 + t; }
constexpr int G1_N16 = 16 * 256, G1_N8 = 22 * 256, G1_LEAD8 = 6 * 256;
constexpr int AW = 1024, KVW = 256, HKW = 1024, HVW = 1024;
constexpr int NEXP = 32, NGRP = 4, EPG = 8, EFF = 512;
constexpr float EPS = 1e-6f;
constexpr int LIST_CAP = 32768;

typedef unsigned short bf16_t;
__device__ __forceinline__ float bf2f(bf16_t v) { return __uint_as_float(((unsigned)v) << 16); }
__device__ __forceinline__ bf16_t f2bf(float f) { unsigned u = __float_as_uint(f); u += 0x7fffu + ((u >> 16) & 1u); return (bf16_t)(u >> 16); }
__device__ __forceinline__ float sigmoidf_(float x) { return 1.f / (1.f + __expf(-x)); }

constexpr size_t MiB = 1u << 20;
constexpr size_t WS_CTL = 0;
constexpr size_t WS_RS1 = 1 * MiB;
constexpr size_t WS_RS2 = 1 * MiB + 65536;
constexpr size_t WS_LB = 1 * MiB + 131072;
constexpr size_t WS_EID = 2 * MiB;
constexpr size_t WS_EW = 2 * MiB + 131072;
constexpr size_t WS_WRH = 2 * MiB + 262144, WS_WRL = 2 * MiB + 524288;
constexpr size_t WS_LIST = 3 * MiB;
constexpr size_t WS_WIN = 8 * MiB, WS_WAR = 46 * MiB, WS_WOUT = 54 * MiB, WS_WGU = 62 * MiB, WS_WDN = 190 * MiB;
constexpr size_t WS_QA = 254 * MiB, WS_KA = 286 * MiB, WS_VA = 294 * MiB, WS_QH = 302 * MiB, WS_GH = 334 * MiB, WS_IH = 398 * MiB, WS_GO = 430 * MiB;
constexpr size_t WS_SGA = 462 * MiB, WS_SGB = 526 * MiB;
constexpr size_t WS_HST = 590 * MiB;
constexpr size_t WS_END = 608 * MiB;
constexpr size_t WS_MIX = 254 * MiB, WS_XB2 = 318 * MiB, WS_HB = 382 * MiB;
constexpr size_t WS_YB = 462 * MiB;
constexpr size_t WS_WIN8 = WS_WIN + 22 * MiB;
constexpr size_t WS_XF2 = WS_WGU + 64 * MiB;
constexpr size_t WS_LISTW = WS_HST + 2 * MiB, WS_LISTR = WS_HST + 6 * MiB;
constexpr size_t WS_SS2P = WS_HST;

struct Params {
    const float *x, *norm1_g, *w_in, *sinks, *rel_bias, *lb_logits, *hg_norm_g, *w_a, *w_r, *w_out, *norm2_g, *w_gr, *b_gr, *w_er, *b_er, *w_gate, *w_up, *w_down, *final_g;
    float* out; unsigned char* ws;
};

__device__ __forceinline__ float wave_sum(float v) {
#pragma unroll
    for (int o = 1; o < 64; o <<= 1) v += __shfl_xor(v, o);
    return v;
}

__global__ void __launch_bounds__(256) bl_rowstat(Params p) {
    const int lane = threadIdx.x & 63, gw = (blockIdx.x * 256 + threadIdx.x) >> 6, ngw = (gridDim.x * 256) >> 6;
    float* rs1 = (float*)(p.ws + WS_RS1);
    for (int r = gw; r < NTOK; r += ngw) {
        const float* xr = p.x + (size_t)r * DM; float s = 0.f;
        for (int i = lane; i < DM; i += 64) { float v = xr[i]; s += v * v; }
        s = wave_sum(s);
        if (lane == 0) rs1[r] = 1.f / sqrtf(s * (1.f / DM) + EPS);
    }
    if (blockIdx.x == 0) {
        float* lb = (float*)(p.ws + WS_LB);
        for (int j = threadIdx.x; j < HKW; j += 256) { float l0 = p.lb_logits[j], l1 = p.lb_logits[HKW + j]; lb[j] = 1.f / (1.f + __expf(l1 - l0)); }
    }
    if (blockIdx.x == 1 && threadIdx.x < 64) ((int*)(p.ws + WS_CTL))[threadIdx.x] = 0;
}

struct RowDesc { const void* p; float s; };

template <class AL, class BL, class EP, bool DUAL>
__device__ __forceinline__ void bl_gemm_tile(const AL& al, const BL& bl, const EP& ep, int m0, int n0, int K, float (*As)[132], float (*Bs)[132], float (*Bs2)[132]) {
    const int tid = threadIdx.x, tx = tid & 15, ty = tid >> 4;
    float acc[8][8], acc2[DUAL ? 8 : 1][8];
#pragma unroll
    for (int i = 0; i < 8; ++i)
#pragma unroll
        for (int j = 0; j < 8; ++j) { acc[i][j] = 0.f; if (DUAL) acc2[i][j] = 0.f; }
    RowDesc rd[4];
#pragma unroll
    for (int i = 0; i < 4; ++i) rd[i] = al.row(m0 + (tid >> 3) + 32 * i);
    const int ak = tid & 7;
    for (int k0 = 0; k0 < K; k0 += 8) {
        float av[4], bv[4], bv2[4];
#pragma unroll
        for (int i = 0; i < 4; ++i) av[i] = al.ld(rd[i], k0 + ak);
#pragma unroll
        for (int i = 0; i < 4; ++i) { const int idx = tid + 256 * i, kk = idx >> 7, cc = idx & 127; bv[i] = bl.ld(k0 + kk, n0 + cc); if (DUAL) bv2[i] = bl.ld2(k0 + kk, n0 + cc); }
        __syncthreads();
#pragma unroll
        for (int i = 0; i < 4; ++i) As[ak][(tid >> 3) + 32 * i] = av[i];
#pragma unroll
        for (int i = 0; i < 4; ++i) { const int idx = tid + 256 * i, kk = idx >> 7, cc = idx & 127; Bs[kk][cc] = bv[i]; if (DUAL) Bs2[kk][cc] = bv2[i]; }
        __syncthreads();
#pragma unroll
        for (int kk = 0; kk < 8; ++kk) {
            float a[8], b[8], b2[8];
#pragma unroll
            for (int i = 0; i < 8; ++i) a[i] = As[kk][ty * 8 + i];
#pragma unroll
            for (int j = 0; j < 8; ++j) { b[j] = Bs[kk][tx * 8 + j]; if (DUAL) b2[j] = Bs2[kk][tx * 8 + j]; }
#pragma unroll
            for (int i = 0; i < 8; ++i)
#pragma unroll
                for (int j = 0; j < 8; ++j) { acc[i][j] += a[i] * b[j]; if (DUAL) acc2[i][j] += a[i] * b2[j]; }
        }
    }
#pragma unroll
    for (int i = 0; i < 8; ++i)
#pragma unroll
        for (int j = 0; j < 8; ++j) ep(m0 + ty * 8 + i, n0 + tx * 8 + j, acc[i][j], DUAL ? acc2[i][j] : 0.f);
}

struct ALx { const float* x; const float* rs; const float* g;
    __device__ RowDesc row(int m) const { RowDesc d; d.p = x + (size_t)m * DM; d.s = rs[m]; return d; }
    __device__ float ld(const RowDesc& d, int k) const { return ((const float*)d.p)[k] * d.s * g[k]; } };
struct ALbf { const bf16_t* a; int lda;
    __device__ RowDesc row(int m) const { RowDesc d; d.p = a + (size_t)m * lda; d.s = 1.f; return d; }
    __device__ float ld(const RowDesc& d, int k) const { return bf2f(((const bf16_t*)d.p)[k]); } };
struct BLf { const float* b; int ldb;
    __device__ float ld(int k, int n) const { return b[(size_t)k * ldb + n]; }
    __device__ float ld2(int k, int n) const { return 0.f; } };

struct EpG1 { unsigned char* ws; const float* rs1; const float* lb;
    __device__ void operator()(int m, int c, float acc, float) const {
        const float v = acc * rs1[m];
        if (c < 1024) ((bf16_t*)(ws + WS_QA))[(size_t)m * 1024 + c] = f2bf(v * 0.125f);
        else if (c < 1280) ((bf16_t*)(ws + WS_KA))[(size_t)m * 256 + c - 1024] = f2bf(v);
        else if (c < 1536) ((bf16_t*)(ws + WS_VA))[(size_t)m * 256 + c - 1280] = f2bf(v);
        else if (c < 2560) ((bf16_t*)(ws + WS_QH))[(size_t)m * 1024 + c - 1536] = f2bf(v);
        else if (c < 3584) { const int j = c - 2560; const float l = lb[j], f = l + (1.f - l) * sigmoidf_(v); ((float*)(ws + WS_GH))[(size_t)m * 1024 + j] = __logf(f); }
        else if (c < 4608) ((bf16_t*)(ws + WS_IH))[(size_t)m * 1024 + c - 3584] = f2bf(v);
        else if (c < 5632) ((bf16_t*)(ws + WS_GO))[(size_t)m * 1024 + c - 4608] = f2bf(v);
        else if (c < 7680) ((bf16_t*)(ws + WS_SGA))[(size_t)m * 2048 + c - 5632] = f2bf(sigmoidf_(v));
        else ((bf16_t*)(ws + WS_SGB))[(size_t)m * 2048 + c - 7680] = f2bf(sigmoidf_(v));
    } };

__global__ void __launch_bounds__(256) bl_g1(Params p) {
    __shared__ float As[8][132], Bs[8][132];
    ALx al{p.x, (const float*)(p.ws + WS_RS1), p.norm1_g}; BLf bl{p.w_in, INW}; EpG1 ep{p.ws, (const float*)(p.ws + WS_RS1), (const float*)(p.ws + WS_LB)};
    bl_gemm_tile<ALx, BLf, EpG1, false>(al, bl, ep, blockIdx.y * 128, blockIdx.x * 128, DM, As, Bs, nullptr);
}

__device__ __constant__ unsigned char T5B[128] = {0, 1, 2, 3, 4, 5, 6, 7, 8, 9, 10, 11, 12, 13, 14, 15, 16, 16, 16, 17, 17, 18, 18, 18, 19, 19, 19, 20, 20, 20, 20, 21, 21, 21, 21, 22, 22, 22, 22, 22, 23, 23, 23, 23, 23, 23, 24, 24, 24, 24, 24, 24, 25, 25, 25, 25, 25, 25, 25, 26, 26, 26, 26, 26, 26, 26, 26, 27, 27, 27, 27, 27, 27, 27, 27, 27, 27, 28, 28, 28, 28, 28, 28, 28, 28, 28, 28, 29, 29, 29, 29, 29, 29, 29, 29, 29, 29, 29, 29, 30, 30, 30, 30, 30, 30, 30, 30, 30, 30, 30, 30, 30, 30, 31, 31, 31, 31, 31, 31, 31, 31, 31, 31, 31, 31, 31, 31, 31};

__global__ void __launch_bounds__(256) bl_attn(Params p) {
    const int gid = blockIdx.x * 256 + threadIdx.x;
    const int tok = gid >> 4, h = gid & 15, kvh = h >> 2, b = tok / SEQ, pos = tok % SEQ;
    const bf16_t* QA = (const bf16_t*)(p.ws + WS_QA); const bf16_t* KA = (const bf16_t*)(p.ws + WS_KA); const bf16_t* VA = (const bf16_t*)(p.ws + WS_VA);
    bf16_t* AR = (bf16_t*)((unsigned char*)p.out + 64 * MiB);
    float q[64], o[64];
#pragma unroll
    for (int d = 0; d < 64; ++d) { q[d] = bf2f(QA[(size_t)tok * 1024 + h * 64 + d]); o[d] = 0.f; }
    float m = p.sinks[h], l = 1.f;
    const int blk0 = (pos / 128) * 128;
    int lo = pos - 127; if (lo < 0) lo = 0; if (lo < blk0 - 128) lo = blk0 - 128;
    for (int kp = lo; kp <= pos; ++kp) {
        const size_t kr = (size_t)(b * SEQ + kp) * 256 + kvh * 64;
        float s = 0.f;
#pragma unroll
        for (int d = 0; d < 64; ++d) s += q[d] * bf2f(KA[kr + d]);
        s += p.rel_bias[T5B[pos - kp] * 16 + h];
        const float mn = fmaxf(m, s), sc = __expf(m - mn), pe = __expf(s - mn);
        l = l * sc + pe;
#pragma unroll
        for (int d = 0; d < 64; ++d) o[d] = o[d] * sc + pe * bf2f(VA[kr + d]);
        m = mn;
    }
    const float inv = 1.f / l;
#pragma unroll
    for (int d = 0; d < 64; ++d) AR[(size_t)tok * 2048 + h * 64 + d] = f2bf(o[d] * inv);
}

__global__ void __launch_bounds__(128) bl_hgrn(Params p) {
    const int b = blockIdx.x >> 3, h = blockIdx.x & 7, v = threadIdx.x;
    const bf16_t* QH = (const bf16_t*)(p.ws + WS_QH); const float* GH = (const float*)(p.ws + WS_GH); const bf16_t* IH = (const bf16_t*)(p.ws + WS_IH); const bf16_t* GO = (const bf16_t*)(p.ws + WS_GO);
    bf16_t* AR = (bf16_t*)((unsigned char*)p.out + 64 * MiB);
    __shared__ float sq[8][128], sf[8][128], red[2];
    float S[128];
#pragma unroll
    for (int k = 0; k < 128; ++k) S[k] = 0.f;
    const float gn = p.hg_norm_g[v];
    for (int t0 = 0; t0 < SEQ; t0 += 8) {
        __syncthreads();
#pragma unroll
        for (int i = 0; i < 8; ++i) { const size_t r = (size_t)(b * SEQ + t0 + i) * 1024 + h * 128 + v; sq[i][v] = bf2f(QH[r]); sf[i][v] = __expf(GH[r]); }
        __syncthreads();
        for (int i = 0; i < 8; ++i) {
            const size_t r = (size_t)(b * SEQ + t0 + i) * 1024 + h * 128 + v;
            const float vi = bf2f(IH[r]); float o = 0.f;
#pragma unroll
            for (int k = 0; k < 128; ++k) { const float f = sf[i][k]; S[k] = f * S[k] + (1.f - f) * vi; o += sq[i][k] * S[k]; }
            float ss = wave_sum(o * o);
            __syncthreads();
            if ((v & 63) == 0) red[v >> 6] = ss;
            __syncthreads();
            const float tot = red[0] + red[1];
            const float go = bf2f(GO[r]);
            const float y = o * (1.f / sqrtf(tot * (1.f / 128.f) + EPS)) * gn * (go * sigmoidf_(go));
            AR[(size_t)(b * SEQ + t0 + i) * 2048 + 1024 + h * 128 + v] = f2bf(y);
        }
    }
}

struct EpMixA { bf16_t* mix; const bf16_t* sg;
    __device__ void operator()(int m, int c, float acc, float) const { const size_t i = (size_t)m * 2048 + c; mix[i] = f2bf(bf2f(sg[i]) * acc); } };
struct EpMixB { bf16_t* mix; const bf16_t* sg;
    __device__ void operator()(int m, int c, float acc, float) const { const size_t i = (size_t)m * 2048 + c; mix[i] = f2bf(bf2f(mix[i]) + bf2f(sg[i]) * acc); } };
__global__ void __launch_bounds__(256) bl_branch(Params p, int which) {
    __shared__ float As[8][132], Bs[8][132];
    const bf16_t* AR = (const bf16_t*)((unsigned char*)p.out + 64 * MiB);
    if (which == 0) { ALbf al{AR, 2048}; BLf bl{p.w_a, DM}; EpMixA ep{(bf16_t*)(p.ws + WS_MIX), (const bf16_t*)(p.ws + WS_SGA)};
        bl_gemm_tile<ALbf, BLf, EpMixA, false>(al, bl, ep, blockIdx.y * 128, blockIdx.x * 128, 1024, As, Bs, nullptr); }
    else { ALbf al{AR + 1024, 2048}; BLf bl{p.w_r, DM}; EpMixB ep{(bf16_t*)(p.ws + WS_MIX), (const bf16_t*)(p.ws + WS_SGB)};
        bl_gemm_tile<ALbf, BLf, EpMixB, false>(al, bl, ep, blockIdx.y * 128, blockIdx.x * 128, 1024, As, Bs, nullptr); }
}
struct EpRes { const float* x; float* out;
    __device__ void operator()(int m, int c, float acc, float) const { const size_t i = (size_t)m * 2048 + c; out[i] = x[i] + acc; } };
__global__ void __launch_bounds__(256) bl_g3(Params p) {
    __shared__ float As[8][132], Bs[8][132];
    ALbf al{(const bf16_t*)(p.ws + WS_MIX), 2048}; BLf bl{p.w_out, DM}; EpRes ep{p.x, p.out};
    bl_gemm_tile<ALbf, BLf, EpRes, false>(al, bl, ep, blockIdx.y * 128, blockIdx.x * 128, DM, As, Bs, nullptr);
}

__global__ void __launch_bounds__(256) bl_router(Params p) {
    const int lane = threadIdx.x & 63, gw = (blockIdx.x * 256 + threadIdx.x) >> 6, ngw = (gridDim.x * 256) >> 6;
    float* rs2 = (float*)(p.ws + WS_RS2); bf16_t* XB2 = (bf16_t*)(p.ws + WS_XB2); int* EID = (int*)(p.ws + WS_EID); float* EW = (float*)(p.ws + WS_EW);
    int* CNT = (int*)(p.ws + WS_CTL); int* LIST = (int*)(p.ws + WS_LIST);
    for (int r = gw; r < NTOK; r += ngw) {
        const float* xr = p.out + (size_t)r * DM;
        float ss = 0.f, lg[36];
#pragma unroll
        for (int e = 0; e < 36; ++e) lg[e] = 0.f;
        for (int i = 0; i < DM / 64; ++i) {
            const int k = lane + 64 * i; const float xv = xr[k]; ss += xv * xv;
            XB2[(size_t)r * DM + k] = f2bf(xv);
            const float hv = xv * p.norm2_g[k];
#pragma unroll
            for (int e = 0; e < 4; ++e) lg[e] += hv * p.w_gr[k * 4 + e];
#pragma unroll
            for (int e = 0; e < 32; ++e) lg[4 + e] += hv * p.w_er[k * 32 + e];
        }
        ss = wave_sum(ss);
#pragma unroll
        for (int e = 0; e < 36; ++e) lg[e] = wave_sum(lg[e]);
        const float rstd = 1.f / sqrtf(ss * (1.f / DM) + EPS);
        if (lane == 0) {
            rs2[r] = rstd;
            float gl[4]; int gi = 0;
#pragma unroll
            for (int e = 0; e < 4; ++e) gl[e] = lg[e] * rstd + p.b_gr[e];
            float gm = gl[0];
#pragma unroll
            for (int e = 1; e < 4; ++e) if (gl[e] > gm) { gm = gl[e]; gi = e; }
            float gs = 0.f;
#pragma unroll
            for (int e = 0; e < 4; ++e) gs += __expf(gl[e] - gm);
            const float gw_ = 1.f / gs;
            float el[8];
#pragma unroll
            for (int e = 0; e < 8; ++e) { float v = 0.f;
#pragma unroll
                for (int g = 0; g < 4; ++g) v = (g == gi) ? lg[4 + g * 8 + e] : v;
                el[e] = v * rstd + p.b_er[gi * 8 + e]; }
            int i1 = 0; float m1 = el[0];
#pragma unroll
            for (int e = 1; e < 8; ++e) if (el[e] > m1) { m1 = el[e]; i1 = e; }
            int i2 = -1; float m2 = -3.0e38f;
#pragma unroll
            for (int e = 0; e < 8; ++e) if (e != i1 && el[e] > m2) { m2 = el[e]; i2 = e; }
            const float p2 = __expf(m2 - m1);
            const float w1 = gw_ / (1.f + p2), w2 = gw_ * p2 / (1.f + p2);
            const int e1 = gi * 8 + i1, e2 = gi * 8 + i2;
            EID[2 * r] = e1; EID[2 * r + 1] = e2; EW[2 * r] = w1; EW[2 * r + 1] = w2;
            const int p1 = atomicAdd(&CNT[e1], 1); LIST[e1 * LIST_CAP + p1] = 2 * r;
            const int p2_ = atomicAdd(&CNT[e2], 1); LIST[e2 * LIST_CAP + p2_] = 2 * r + 1;
        }
    }
}

__device__ __forceinline__ bool moe_map(const int* CNT, int by, int& e, int& i0, int& cnt, int& hb0) {
    int t = by, off = 0;
    for (int ee = 0; ee < NEXP; ++ee) { const int c = CNT[ee], nt = (c + 127) >> 7; if (t < nt) { e = ee; i0 = t * 128; cnt = c; hb0 = off + i0; return true; } t -= nt; off += ((c + 255) >> 8) << 8; }
    return false;
}
struct ALmoe1 { const bf16_t* xb2; const float* rs2; const float* g2; const int* list; int i0, cnt;
    __device__ RowDesc row(int m) const { RowDesc d; const int i = i0 + m; if (i < cnt) { const int tok = list[i] >> 1; d.p = xb2 + (size_t)tok * DM; d.s = rs2[tok]; } else { d.p = xb2; d.s = 0.f; } return d; }
    __device__ float ld(const RowDesc& d, int k) const { return bf2f(((const bf16_t*)d.p)[k]) * d.s * g2[k]; } };
struct BLgu { const float* wg; const float* wu;
    __device__ float ld(int k, int n) const { return wg[(size_t)k * EFF + n]; }
    __device__ float ld2(int k, int n) const { return wu[(size_t)k * EFF + n]; } };
struct EpHB { bf16_t* hb; int hb0;
    __device__ void operator()(int m, int c, float g, float u) const { hb[(size_t)(hb0 + m) * EFF + c] = f2bf(g * sigmoidf_(g) * u); } };
__global__ void __launch_bounds__(256) bl_moe1(Params p) {
    __shared__ float As[8][132], Bs[8][132], Bs2[8][132];
    const int* CNT = (const int*)(p.ws + WS_CTL); int e, i0, cnt, hb0;
    if (!moe_map(CNT, blockIdx.y, e, i0, cnt, hb0)) return;
    ALmoe1 al{(const bf16_t*)(p.ws + WS_XB2), (const float*)(p.ws + WS_RS2), p.norm2_g, (const int*)(p.ws + WS_LIST) + e * LIST_CAP, i0, cnt};
    BLgu bl{p.w_gate + (size_t)e * DM * EFF, p.w_up + (size_t)e * DM * EFF}; EpHB ep{(bf16_t*)(p.ws + WS_HB), hb0};
    bl_gemm_tile<ALmoe1, BLgu, EpHB, true>(al, bl, ep, 0, blockIdx.x * 128, DM, As, Bs, Bs2);
}
struct EpYB { bf16_t* yb; const float* ew; const int* list; int i0, cnt;
    __device__ void operator()(int m, int c, float acc, float) const { const int i = i0 + m; if (i < cnt) { const int slot = list[i]; yb[(size_t)slot * DM + c] = f2bf(acc * ew[slot]); } } };
__global__ void __launch_bounds__(256) bl_moe2(Params p) {
    __shared__ float As[8][132], Bs[8][132];
    const int* CNT = (const int*)(p.ws + WS_CTL); int e, i0, cnt, hb0;
    if (!moe_map(CNT, blockIdx.y, e, i0, cnt, hb0)) return;
    ALbf al{(const bf16_t*)(p.ws + WS_HB) + (size_t)hb0 * EFF, EFF}; BLf bl{p.w_down + (size_t)e * EFF * DM, DM};
    EpYB ep{(bf16_t*)(p.ws + WS_YB), (const float*)(p.ws + WS_EW), (const int*)(p.ws + WS_LIST) + e * LIST_CAP, i0, cnt};
    bl_gemm_tile<ALbf, BLf, EpYB, false>(al, bl, ep, 0, blockIdx.x * 128, EFF, As, Bs, nullptr);
}

__global__ void __launch_bounds__(256) bl_final(Params p) {
    const int lane = threadIdx.x & 63, gw = (blockIdx.x * 256 + threadIdx.x) >> 6, ngw = (gridDim.x * 256) >> 6;
    const bf16_t* YB = (const bf16_t*)(p.ws + WS_YB);
    for (int r = gw; r < NTOK; r += ngw) {
        float* xr = p.out + (size_t)r * DM; float v[DM / 64]; float ss = 0.f;
#pragma unroll
        for (int i = 0; i < DM / 64; ++i) { const int k = lane + 64 * i; v[i] = xr[k] + bf2f(YB[(size_t)(2 * r) * DM + k]) + bf2f(YB[(size_t)(2 * r + 1) * DM + k]); ss += v[i] * v[i]; }
        ss = wave_sum(ss);
        const float rstd = 1.f / sqrtf(ss * (1.f / DM) + EPS);
#pragma unroll
        for (int i = 0; i < DM / 64; ++i) { const int k = lane + 64 * i; xr[k] = v[i] * rstd * p.final_g[k]; }
    }
}


#define LAS_ __attribute__((address_space(3)))
__device__ __forceinline__ unsigned pk4_fp8(float a, float b, float c, float d) { int w = 0; w = __builtin_amdgcn_cvt_pk_fp8_f32(a, b, w, false); w = __builtin_amdgcn_cvt_pk_fp8_f32(c, d, w, true); return (unsigned)w; }
typedef _Float16 h16x2 __attribute__((ext_vector_type(2)));
__device__ __forceinline__ unsigned pk2_h16(float a, float b) { h16x2 v = {(_Float16)a, (_Float16)b}; return __builtin_bit_cast(unsigned, v); }
__device__ __forceinline__ float h16_lo(unsigned w) { return (float)__builtin_bit_cast(h16x2, w).x; }
__device__ __forceinline__ float h16_hi(unsigned w) { return (float)__builtin_bit_cast(h16x2, w).y; }
constexpr float WGU_SCALE = 64.f, WDN_SCALE = 32.f, WIN8_SCALE = 64.f, YB_SCALE = 16.f;
namespace pg8 {
#define PG8_LAS __attribute__((address_space(3)))
typedef short bf16x8 __attribute__((ext_vector_type(8)));
typedef float f32x4 __attribute__((ext_vector_type(4)));
typedef unsigned u32x4 __attribute__((ext_vector_type(4)));
typedef unsigned u32x2 __attribute__((ext_vector_type(2)));
typedef int v4i __attribute__((ext_vector_type(4)));
typedef int v8i __attribute__((ext_vector_type(8)));
constexpr int KROT = 1;
constexpr int BM = 256, BK = 64, HALF = 128, HTB = HALF * BK * 2, STAGE_BYTES = 8 * HTB, NXCD = 8, WGM = 8;

__host__ __device__ __forceinline__ int lds_byte(int r, int c) { const int st = (r >> 4) * 2 + (c >> 5), rr = r & 15, cc = c & 31, ob = rr * 64 + cc * 2; return st * 1024 + (ob ^ (((ob >> 9) & 1) << 5)); }
__host__ __device__ __forceinline__ void stage_rc(int b, int& R, int& C) { const int st = b / 1024, sb = b % 1024, swz = sb ^ (((sb >> 9) & 1) << 5); R = (st >> 1) * 16 + swz / 64; C = (st & 1) * 32 + (swz % 64) / 2; }
__host__ __device__ __forceinline__ int perm32(int rho) { const int n = rho >> 4, i = rho & 15; return 8 * (i >> 2) + 4 * n + (i & 3); }

struct Unit { int pm, pn, e, i0, cnt, aux; };

struct StaticOrder {
    int nM, nN, nwg, G, c, wgm; const char* A; const char* B; size_t tstep;
    __device__ void init(int M, int N, int KBytes, int G_, int c_, const void* A_, const void* B_, int wgm_) { nM = M / BM; nN = N / BM; nwg = nM * nN; G = G_; c = c_; wgm = wgm_; A = (const char*)A_; B = (const char*)B_; tstep = (size_t)BM * KBytes; }
    __device__ __forceinline__ bool next(int i, Unit& u) const {
        const long L = (long)i * G + c; if (L >= nwg) return false;
        int wgid = (int)L; { const int q = nwg / NXCD, r = nwg % NXCD, xcd = wgid % NXCD, off = wgid / NXCD; wgid = (xcd < r ? xcd * (q + 1) : r * (q + 1) + (xcd - r) * q) + off; }
        const int nig = wgm * nN, gid = wgid / nig, fm = gid * wgm, gsz = (nM - fm) < wgm ? (nM - fm) : wgm;
        u.pm = fm + ((wgid % nig) % gsz); u.pn = (wgid % nig) / gsz; u.e = 0; u.i0 = 0; u.cnt = 0; u.aux = KROT ? gid * 4 : 0; return true;
    }
    __device__ __forceinline__ const char* Aptr(const Unit& u) const { return A + (size_t)u.pm * tstep; }
    __device__ __forceinline__ const char* Bptr(const Unit& u) const { return B + (size_t)u.pn * tstep; }
    __device__ __forceinline__ unsigned rowoff(const Unit&, int) const { return 0u; }
};

__device__ __forceinline__ unsigned cvt_pk_bf16(float lo, float hi) { unsigned r; asm volatile("v_cvt_pk_bf16_f32 %0, %1, %2" : "=v"(r) : "v"(lo), "v"(hi)); return r; }

template <class Epi, class Sched, bool ALIGN_EPI, bool GATHER, bool FP8 = false>
__device__ __forceinline__ void gemm_phase(PG8_LAS unsigned char* lds, const int K, const Sched& S, const Epi& E) {
    int tid_o = threadIdx.x; asm volatile("" : "+v"(tid_o));
    const int tid = tid_o, wid = __builtin_amdgcn_readfirstlane(tid >> 6), lane = tid & 63, wr = wid >> 2, wc = wid & 3, fr = lane & 15, fq = lane >> 4;
    int KB = FP8 ? K : 2 * K;
    asm volatile("" : "+s"(KB));
    const int nt = KB / (BK * 2);
    Unit cur, nxt; int ui = 0;
    if (!S.next(0, cur)) return;
    unsigned voffA[2][2], voffB[2];
#pragma unroll
    for (int i = 0; i < 2; ++i) { int R, C; stage_rc(tid * 16 + i * 8192, R, C); const int Rb = Epi::PERM ? ((R & ~31) + perm32(R & 31)) : R;
        voffB[i] = (unsigned)(Rb * KB + C * 2);
        if constexpr (GATHER) { voffA[0][i] = S.rowoff(cur, R) + (unsigned)C * 2u; voffA[1][i] = S.rowoff(cur, R + HALF) + (unsigned)C * 2u; }
        else { voffA[0][i] = (unsigned)(R * KB + C * 2); voffA[1][i] = voffA[0][i]; } }
    const unsigned kstep = (unsigned)(BK * 2);
    const size_t hstep = (size_t)HALF * KB;
    const size_t hstepA = GATHER ? 0 : hstep;
    const unsigned ldsw = (unsigned)wid * 1024u;
    const int aoff = lds_byte(wr * 64 + fr, fq * 8), boff = lds_byte(wc * 32 + fr, fq * 8);
#define PG8_SA(b, h) (((b) * 2 + (h)) * HTB)
#define PG8_SB(b, h) ((4 + (b) * 2 + (h)) * HTB)
#define PG8_STAGE(bufoff, gbase, voff) do { _Pragma("unroll") for (int _i = 0; _i < 2; ++_i) \
        __builtin_amdgcn_global_load_lds((const unsigned*)((const char*)(gbase) + (voff)[_i]), (PG8_LAS unsigned*)(lds + (bufoff) + ldsw + _i * 8192), 16, 0, 0); } while (0)
#define PG8_LD32(addr) __builtin_shufflevector(*(const PG8_LAS v4i*)(addr), *(const PG8_LAS v4i*)((addr) + 1024), 0, 1, 2, 3, 4, 5, 6, 7)
#define PG8_LDA(dst, b, h) do { _Pragma("unroll") for (int m = 0; m < 4; ++m) dst[m] = PG8_LD32(lds + PG8_SA(b, h) + aoff + m * 2048); } while (0)
#define PG8_LDB(dst, b, h) do { _Pragma("unroll") for (int n = 0; n < 2; ++n) dst[n] = PG8_LD32(lds + PG8_SB(b, h) + boff + n * 2048); } while (0)
#define PG8_HALF0(x) __builtin_bit_cast(bf16x8, __builtin_shufflevector((x), (x), 0, 1, 2, 3))
#define PG8_HALF1(x) __builtin_bit_cast(bf16x8, __builtin_shufflevector((x), (x), 4, 5, 6, 7))
#define PG8_MMA(ai, bj, At, Bt) do { __builtin_amdgcn_s_setprio(1); _Pragma("unroll") for (int m = 0; m < 4; ++m) _Pragma("unroll") for (int n = 0; n < 2; ++n) { \
        if constexpr (FP8) asm volatile("v_mfma_scale_f32_16x16x128_f8f6f4 %0, %1, %2, %0, %3, %3 op_sel_hi:[0,0,0]" : "+v"(acc[ai][bj][m][n]) : "v"(Bt[n]), "v"(At[m]), "v"(sc1));   \
        else { acc[ai][bj][m][n] = __builtin_amdgcn_mfma_f32_16x16x32_bf16(PG8_HALF0(Bt[n]), PG8_HALF0(At[m]), acc[ai][bj][m][n], 0, 0, 0); \
               acc[ai][bj][m][n] = __builtin_amdgcn_mfma_f32_16x16x32_bf16(PG8_HALF1(Bt[n]), PG8_HALF1(At[m]), acc[ai][bj][m][n], 0, 0, 0); } } \
        __builtin_amdgcn_s_setprio(0); } while (0)
#define PG8_WAIT_V(n) asm volatile("s_waitcnt vmcnt(" #n ")" ::: "memory")
#define PG8_WAIT_L(n) asm volatile("s_waitcnt lgkmcnt(" #n ")" ::: "memory")
#define PG8_BAR __builtin_amdgcn_s_barrier()
#define PG8_SCHED __builtin_amdgcn_sched_barrier(0)
    f32x4 acc[2][2][4][2];
#pragma unroll
    for (int a = 0; a < 2; ++a)
#pragma unroll
        for (int b = 0; b < 2; ++b)
#pragma unroll
            for (int m = 0; m < 4; ++m)
#pragma unroll
                for (int n = 0; n < 2; ++n) acc[a][b][m][n] = (f32x4){0.f, 0.f, 0.f, 0.f};
    const int sc1 = 0x7f7f7f7f;
    v8i At[4], B0[2], B1[2];
    const char* cA = S.Aptr(cur); const char* cB = S.Bptr(cur);
    PG8_LAS unsigned* prebuf = (PG8_LAS unsigned*)(lds + STAGE_BYTES);
    unsigned pnv = 0u;
    if constexpr (Epi::PRE) { const void* pa = E.pre_addr(cur, tid); asm volatile("global_load_dword %0, %1, off" : "+v"(pnv) : "v"(pa) : "memory"); }
    const unsigned k0o = (unsigned)(Epi::HAS_MID ? (cur.aux & ((nt >> 1) - 1)) : (cur.aux & (nt - 1))) * kstep, k1o = (unsigned)(Epi::HAS_MID ? ((1 + cur.aux) & ((nt >> 1) - 1)) : ((1 + cur.aux) & (nt - 1))) * kstep;
    PG8_STAGE(PG8_SB(0, 0), cB + k0o, voffB); PG8_STAGE(PG8_SB(0, 1), cB + hstep + k0o, voffB); PG8_STAGE(PG8_SA(0, 0), cA + k0o, voffA[0]); PG8_STAGE(PG8_SA(0, 1), cA + hstepA + k0o, voffA[1]);
    if (wr == 1) PG8_BAR;
    PG8_WAIT_V(2); PG8_BAR;
    PG8_STAGE(PG8_SB(1, 0), cB + k1o, voffB); PG8_STAGE(PG8_SA(1, 0), cA + k1o, voffA[0]); PG8_STAGE(PG8_SB(1, 1), cB + hstep + k1o, voffB);
    PG8_WAIT_V(6); PG8_BAR;
    for (;;) {
        const bool has_next = S.next(ui + 1, nxt);
        const char* nA = has_next ? S.Aptr(nxt) : cA; const char* nB = has_next ? S.Bptr(nxt) : cB;
        unsigned voffN[2][2];
#pragma unroll
        for (int i = 0; i < 2; ++i) { voffN[0][i] = voffA[0][i]; voffN[1][i] = voffA[1][i];
            if constexpr (GATHER) { if (has_next) { int R, C; stage_rc(tid * 16 + i * 8192, R, C); voffN[0][i] = S.rowoff(nxt, R) + (unsigned)C * 2u; voffN[1][i] = S.rowoff(nxt, R + HALF) + (unsigned)C * 2u; } } }
        for (int t = 0; t < nt; t += 2) {
            if constexpr (Epi::HAS_MID) { if (t == (nt >> 1)) E.mid(acc, cur, wr, wc, fr, fq); }
            const bool last = (t == nt - 2);
#define PG8_KT(x, r0) (Epi::HAS_MID ? (((x) & (nt >> 1)) | (((x) + (r0)) & ((nt >> 1) - 1))) : (((x) + (r0)) & (nt - 1)))
            const int rc = cur.aux, rn = has_next ? nxt.aux : cur.aux;
            const char* a1 = cA + (unsigned)PG8_KT(t + 1, rc) * kstep;
            const char* a2 = last ? nA + (unsigned)PG8_KT(0, rn) * kstep : cA + (unsigned)PG8_KT(t + 2, rc) * kstep; const char* b2 = last ? nB + (unsigned)PG8_KT(0, rn) * kstep : cB + (unsigned)PG8_KT(t + 2, rc) * kstep;
            const char* a3 = last ? nA + (unsigned)PG8_KT(1, rn) * kstep : cA + (unsigned)PG8_KT(t + 3, rc) * kstep; const char* b3 = last ? nB + (unsigned)PG8_KT(1, rn) * kstep : cB + (unsigned)PG8_KT(t + 3, rc) * kstep;
            unsigned vs[2][2];
#pragma unroll
            for (int i = 0; i < 2; ++i) { vs[0][i] = (GATHER && last) ? voffN[0][i] : voffA[0][i]; vs[1][i] = (GATHER && last) ? voffN[1][i] : voffA[1][i]; }
            PG8_LDB(B0, 0, 0); PG8_LDB(B1, 0, 1); PG8_SCHED; PG8_LDA(At, 0, 0); PG8_STAGE(PG8_SA(1, 1), a1 + hstepA, voffA[1]);
            PG8_WAIT_V(8); PG8_WAIT_L(0); PG8_BAR; PG8_MMA(0, 0, At, B0); PG8_MMA(0, 1, At, B1); PG8_BAR; PG8_SCHED;
            PG8_LDA(At, 0, 1); PG8_STAGE(PG8_SB(0, 0), b2, voffB); PG8_STAGE(PG8_SB(0, 1), b2 + hstep, voffB); PG8_STAGE(PG8_SA(0, 0), a2, vs[0]);
            PG8_WAIT_V(8); PG8_WAIT_L(0); PG8_BAR; PG8_MMA(1, 0, At, B0); PG8_MMA(1, 1, At, B1); PG8_BAR; PG8_SCHED;
            PG8_LDB(B0, 1, 0); PG8_LDB(B1, 1, 1); PG8_SCHED; PG8_LDA(At, 1, 0); PG8_STAGE(PG8_SA(0, 1), a2 + hstepA, vs[1]);
            PG8_WAIT_V(8); PG8_WAIT_L(0); PG8_BAR; PG8_MMA(0, 0, At, B0); PG8_MMA(0, 1, At, B1); PG8_BAR; PG8_SCHED;
            PG8_LDA(At, 1, 1); PG8_STAGE(PG8_SB(1, 0), b3, voffB); PG8_STAGE(PG8_SB(1, 1), b3 + hstep, voffB); PG8_STAGE(PG8_SA(1, 0), a3, vs[0]);
            PG8_WAIT_V(8); PG8_WAIT_L(0); PG8_BAR; PG8_MMA(1, 0, At, B0); PG8_MMA(1, 1, At, B1); PG8_BAR; PG8_SCHED;
        }
        if constexpr (ALIGN_EPI) { if (wr == 0) PG8_BAR; }
        if constexpr (FP8) asm volatile("s_nop 15\n\ts_nop 7" ::: "memory");
        if constexpr (Epi::PRE) {
            prebuf[tid] = pnv; PG8_WAIT_L(0); PG8_BAR;
            if (has_next) { const void* pa = E.pre_addr(nxt, tid); asm volatile("global_load_dword %0, %1, off" : "+v"(pnv) : "v"(pa) : "memory"); } }
        E(acc, cur, wr, wc, fr, fq, prebuf);
        if (!has_next) break;
#pragma unroll
        for (int a = 0; a < 2; ++a)
#pragma unroll
            for (int b = 0; b < 2; ++b)
#pragma unroll
                for (int m = 0; m < 4; ++m)
#pragma unroll
                    for (int n = 0; n < 2; ++n) acc[a][b][m][n] = (f32x4){0.f, 0.f, 0.f, 0.f};
        cur = nxt; cA = nA; cB = nB; ++ui;
        if constexpr (GATHER) {
#pragma unroll
            for (int i = 0; i < 2; ++i) { voffA[0][i] = voffN[0][i]; voffA[1][i] = voffN[1][i]; } }
        if constexpr (ALIGN_EPI) { if (wr == 1) PG8_BAR; }
    }
    PG8_WAIT_V(0);
    if constexpr (!ALIGN_EPI) { if (wr == 0) PG8_BAR; }
    PG8_BAR;
#undef PG8_SA
#undef PG8_SB
#undef PG8_STAGE
#undef PG8_LDA
#undef PG8_LDB
#undef PG8_MMA
#undef PG8_KT
#undef PG8_LD32
#undef PG8_HALF0
#undef PG8_HALF1
#undef PG8_WAIT_V
#undef PG8_WAIT_L
#undef PG8_BAR
#undef PG8_SCHED
}

__device__ __forceinline__ float sigm(float x) { return __builtin_amdgcn_rcpf(1.f + __expf(-x)); }

__device__ __forceinline__ u32x4 pair16(u32x2 wa, u32x2 wb, int fq) {
    const bool odd = (fq & 1) != 0; const u32x2 send = odd ? wa : wb; u32x2 recv;
    recv.x = (unsigned)__shfl_xor((int)send.x, 16); recv.y = (unsigned)__shfl_xor((int)send.y, 16);
    return odd ? (u32x4){recv.x, recv.y, wb.x, wb.y} : (u32x4){wa.x, wa.y, recv.x, recv.y};
}
struct EpiG1 {
    static constexpr bool PERM = true, HAS_MID = false, PRE = true;
    unsigned char* ws; const float* rs1; const float* lb; int fp8kind; float sc_extra;
    __device__ __forceinline__ const void* pre_addr(const Unit& u, int tid) const { return rs1 + u.pm * BM + (tid & 255); }
    __device__ __forceinline__ void mid(f32x4 (&)[2][2][4][2], const Unit&, int, int, int, int) const {}
    __device__ __forceinline__ void operator()(const f32x4 (&acc)[2][2][4][2], const Unit& u, int wr, int wc, int fr, int fq, const PG8_LAS unsigned* pre) const {
        const int pn = fp8kind ? g1_code_fp8(u.pn) : g1_code_bf16(u.pn); int mode = 0, ld = 1024, cb = 0; size_t dst = 0; float sc = sc_extra;
        if (pn < 4) { dst = WS_QA; cb = pn * 256; sc *= 0.125f * 1.4426950408889634f; }
        else if (pn == 4) { dst = WS_KA; ld = 256; }
        else if (pn == 5) { dst = WS_VA; ld = 256; }
        else if (pn < 10) { dst = WS_QH; cb = (pn - 6) * 256; }
        else if (pn < 14) { dst = WS_GH; cb = (pn - 10) * 256; mode = 2; }
        else if (pn < 18) { dst = WS_IH; cb = (pn - 14) * 256; }
        else if (pn < 22) { dst = WS_GO; cb = (pn - 18) * 256; }
        else { mode = 3; cb = (pn - 22) * 128; ld = 2048; }
        const int row0 = u.pm * BM + wr * 64 + fr, col0 = cb + wc * 32 + 8 * fq;
        if (mode == 3) {
#pragma unroll
            for (int ai = 0; ai < 2; ++ai)
#pragma unroll
                for (int m = 0; m < 4; ++m) { const int row = row0 + ai * HALF + m * 16; const float rs = __uint_as_float(pre[wr * 64 + fr + ai * HALF + m * 16]) * sc, rsn = rs * -1.4426950408889634f; float ra[8], sb[8];
#pragma unroll
                    for (int n = 0; n < 2; ++n)
#pragma unroll
                        for (int j = 0; j < 4; ++j) { const float ea = __builtin_amdgcn_exp2f(acc[ai][0][m][n][j] * rsn), eb = __builtin_amdgcn_exp2f(acc[ai][1][m][n][j] * rsn);
                            const float pa = 1.f + ea, pb = 1.f + eb, t = __builtin_amdgcn_rcpf(pa * pb);
                            sb[4 * n + j] = pa * t; ra[4 * n + j] = pb * pb * t; }
                    u32x4 wr_, ws_;
#pragma unroll
                    for (int q = 0; q < 4; ++q) { wr_[q] = cvt_pk_bf16(ra[2 * q], ra[2 * q + 1]); ws_[q] = cvt_pk_bf16(sb[2 * q], sb[2 * q + 1]); }
                    __builtin_nontemporal_store(wr_, (u32x4*)((bf16_t*)(ws + WS_SGA) + (size_t)row * ld + col0)); __builtin_nontemporal_store(ws_, (u32x4*)((bf16_t*)(ws + WS_SGB) + (size_t)row * ld + col0)); }
            return; }
#pragma unroll
        for (int ai = 0; ai < 2; ++ai)
#pragma unroll
            for (int m = 0; m < 4; ++m) { const int row = row0 + ai * HALF + m * 16; const float rs = __uint_as_float(pre[wr * 64 + fr + ai * HALF + m * 16]) * sc, rsn = rs * -1.4426950408889634f;
#pragma unroll
                for (int bj = 0; bj < 2; ++bj) { f32x4 v0 = acc[ai][bj][m][0] * rs, v1 = acc[ai][bj][m][1] * rs; const int col = col0 + bj * HALF;
                    if (mode == 2) { const f32x4 l0 = *(const f32x4*)(lb + col), l1 = *(const f32x4*)(lb + col + 4);
#pragma unroll
                        for (int j = 0; j < 4; ++j) { v0[j] = __builtin_amdgcn_logf(l0[j] + (1.f - l0[j]) * __builtin_amdgcn_rcpf(1.f + __builtin_amdgcn_exp2f(acc[ai][bj][m][0][j] * rsn))); v1[j] = __builtin_amdgcn_logf(l1[j] + (1.f - l1[j]) * __builtin_amdgcn_rcpf(1.f + __builtin_amdgcn_exp2f(acc[ai][bj][m][1][j] * rsn))); }
                        u32x4 w; w.x = pk2_h16(v0[0], v0[1]); w.y = pk2_h16(v0[2], v0[3]); w.z = pk2_h16(v1[0], v1[1]); w.w = pk2_h16(v1[2], v1[3]);
                        __builtin_nontemporal_store(w, (u32x4*)((unsigned short*)(ws + dst) + (size_t)row * ld + col)); }
                    else { if (mode == 1) {
#pragma unroll
                            for (int j = 0; j < 4; ++j) { v0[j] = sigm(v0[j]); v1[j] = sigm(v1[j]); } }
                        u32x4 w; w.x = cvt_pk_bf16(v0[0], v0[1]); w.y = cvt_pk_bf16(v0[2], v0[3]); w.z = cvt_pk_bf16(v1[0], v1[1]); w.w = cvt_pk_bf16(v1[2], v1[3]);
                        __builtin_nontemporal_store(w, (u32x4*)((bf16_t*)(ws + dst) + (size_t)row * ld + col)); } } }
    }
};

struct EpiMix {
    static constexpr bool PERM = true, HAS_MID = true, PRE = false;
    const bf16_t* sga; const bf16_t* sgb; bf16_t* mix;
    __device__ __forceinline__ void mid(f32x4 (&acc)[2][2][4][2], const Unit& u, int wr, int wc, int fr, int fq) const {
        unsigned ro = (unsigned)((u.pm * BM + wr * 64 + fr) * 2048 + u.pn * BM + wc * 32 + 8 * fq) * 2u; asm volatile("" : "+v"(ro));
        u32x4 a[2][4][2];
#pragma unroll
        for (int ai = 0; ai < 2; ++ai)
#pragma unroll
            for (int m = 0; m < 4; ++m)
#pragma unroll
                for (int bj = 0; bj < 2; ++bj) a[ai][m][bj] = *(const u32x4*)((const char*)sga + ro + (ai * HALF + m * 16) * (2048 * 2) + bj * HALF * 2);
#pragma unroll
        for (int ai = 0; ai < 2; ++ai)
#pragma unroll
            for (int m = 0; m < 4; ++m)
#pragma unroll
                for (int bj = 0; bj < 2; ++bj)
#pragma unroll
                    for (int j = 0; j < 4; ++j) { const unsigned aw = a[ai][m][bj][j];
                        acc[ai][bj][m][j >> 1][(j & 1) * 2] *= __uint_as_float(aw << 16); acc[ai][bj][m][j >> 1][(j & 1) * 2 + 1] *= __uint_as_float(aw & 0xffff0000u); }
        asm volatile("" ::: "memory");
    }
    __device__ __forceinline__ void operator()(const f32x4 (&acc)[2][2][4][2], const Unit& u, int wr, int wc, int fr, int fq, const PG8_LAS unsigned* pre) const {
        const unsigned off0 = (unsigned)((u.pm * BM + wr * 64 + fr) * 2048 + u.pn * BM + wc * 32 + 8 * fq) * 2u;
#pragma unroll
        for (int ai = 0; ai < 2; ++ai) { unsigned ro = off0 + (unsigned)(ai * HALF * 2048) * 2u; asm volatile("" : "+v"(ro));
            u32x4 b[4][2];
#pragma unroll
            for (int m = 0; m < 4; ++m)
#pragma unroll
                for (int bj = 0; bj < 2; ++bj) b[m][bj] = *(const u32x4*)((const char*)sgb + ro + m * (16 * 2048 * 2) + bj * HALF * 2);
#pragma unroll
            for (int m = 0; m < 4; ++m)
#pragma unroll
                for (int bj = 0; bj < 2; ++bj) { u32x4 w;
#pragma unroll
                    for (int j = 0; j < 4; ++j) { const unsigned bw = b[m][bj][j];
                        w[j] = cvt_pk_bf16(acc[ai][bj][m][j >> 1][(j & 1) * 2] * __uint_as_float(bw << 16), acc[ai][bj][m][j >> 1][(j & 1) * 2 + 1] * __uint_as_float(bw & 0xffff0000u)); }
                    *(u32x4*)((char*)mix + ro + m * (16 * 2048 * 2) + bj * HALF * 2) = w; }
            asm volatile("" ::: "memory"); }
    }
};
struct EpiRes {
    static constexpr bool PERM = true, HAS_MID = false, PRE = false;
    const bf16_t* x; bf16_t* xb2; float* ss2p; unsigned char* xf2;
    __device__ __forceinline__ void mid(f32x4 (&)[2][2][4][2], const Unit&, int, int, int, int) const {}
    __device__ __forceinline__ void operator()(const f32x4 (&acc)[2][2][4][2], const Unit& u, int wr, int wc, int fr, int fq, const PG8_LAS unsigned* pre) const {
        const unsigned off0 = (unsigned)((u.pm * BM + wr * 64 + fr) * 2048 + u.pn * BM + wc * 32 + 8 * fq);
#pragma unroll
        for (int ai = 0; ai < 2; ++ai)
#pragma unroll
            for (int mp = 0; mp < 1; ++mp) {
                unsigned rb = off0 + (unsigned)((ai * HALF) * 2048); asm volatile("" : "+v"(rb));
                f32x4 xv[4][2][2];
#pragma unroll
                for (int mi = 0; mi < 4; ++mi)
#pragma unroll
                    for (int bj = 0; bj < 2; ++bj) { const u32x4 xw = *(const u32x4*)(x + rb + mi * (16 * 2048) + bj * HALF);
                        xv[mi][bj][0] = (f32x4){__uint_as_float(xw.x << 16), __uint_as_float(xw.x & 0xffff0000u), __uint_as_float(xw.y << 16), __uint_as_float(xw.y & 0xffff0000u)};
                        xv[mi][bj][1] = (f32x4){__uint_as_float(xw.z << 16), __uint_as_float(xw.z & 0xffff0000u), __uint_as_float(xw.w << 16), __uint_as_float(xw.w & 0xffff0000u)}; }
                u32x2 w8s[4][2];
#pragma unroll
                for (int mi = 0; mi < 4; ++mi) { const int m = mi; const unsigned ro = rb + mi * (16 * 2048); float ss = 0.f;
#pragma unroll
                    for (int bj = 0; bj < 2; ++bj) { const f32x4 v0 = xv[mi][bj][0] + acc[ai][bj][m][0], v1 = xv[mi][bj][1] + acc[ai][bj][m][1];
                        ss += (v0[0] * v0[0] + v0[1] * v0[1]) + (v0[2] * v0[2] + v0[3] * v0[3]) + (v1[0] * v1[0] + v1[1] * v1[1]) + (v1[2] * v1[2] + v1[3] * v1[3]);
                        u32x4 w; w.x = cvt_pk_bf16(v0[0], v0[1]); w.y = cvt_pk_bf16(v0[2], v0[3]); w.z = cvt_pk_bf16(v1[0], v1[1]); w.w = cvt_pk_bf16(v1[2], v1[3]);
                        *(u32x4*)(xb2 + ro + bj * HALF) = w;
                        w8s[mi][bj].x = pk4_fp8(v0[0], v0[1], v0[2], v0[3]); w8s[mi][bj].y = pk4_fp8(v1[0], v1[1], v1[2], v1[3]); }
                    ss += __shfl_xor(ss, 16); ss += __shfl_xor(ss, 32);
                    if (fq == 0) ss2p[(size_t)(u.pm * BM + wr * 64 + fr + ai * HALF + m * 16) * 32 + u.pn * 4 + wc] = ss; }
#pragma unroll
                for (int mp2 = 0; mp2 < 2; ++mp2)
#pragma unroll
                    for (int bj = 0; bj < 2; ++bj) { const u32x4 q = pair16(w8s[2 * mp2][bj], w8s[2 * mp2 + 1][bj], fq);
                        *(u32x4*)(xf2 + rb + (2 * mp2 + (fq & 1)) * (16 * 2048) + bj * HALF - 8 * (fq & 1)) = q; }
                asm volatile("" ::: "memory"); }
    }
};
__device__ __forceinline__ int expert_of_tile(const LAS_ int* tab, int T) {
    const int lane = (int)__builtin_amdgcn_mbcnt_hi(~0u, __builtin_amdgcn_mbcnt_lo(~0u, 0u));
    const int v = tab[32 + (lane & 31)];
    const unsigned long long m = __ballot(lane >= 1 && lane < NEXP && v <= T);
    return (int)__popcll(m);
}
struct MoeSched1 {
    const LAS_ int* tab; int G, c, nunits; const char* xb2; const char* wgu; const int* list;
    __device__ __forceinline__ bool next(int i, Unit& o) const {
        int L;
        if ((G & 7) == 0) {
            const int xcd = c & 7, slot = i * (G >> 3) + (c >> 3), q = nunits >> 3, r = nunits & 7;
            const int len = q + (xcd < r ? 1 : 0); if (slot >= len) return false;
            L = xcd * q + (xcd < r ? xcd : r) + slot;
        } else { L = i * G + c; if (L >= nunits) return false; }
        const int T = L >> 2; const int e = expert_of_tile(tab, T);
        o.pm = T; o.pn = L & 3; o.e = e; o.i0 = (T - tab[32 + e]) * 256; o.cnt = tab[e]; o.aux = 0; return true;
    }
    __device__ __forceinline__ const char* Aptr(const Unit&) const { return xb2; }
    __device__ __forceinline__ const char* Bptr(const Unit& q) const { return wgu + ((size_t)q.e * 1024 + (size_t)q.pn * 256) * DM; }
    __device__ __forceinline__ unsigned rowoff(const Unit& q, int r) const { const int i = q.i0 + r; const int tok = (i < q.cnt) ? (list[q.e * LIST_CAP + i] >> 1) : 0; return (unsigned)tok * (unsigned)DM; }
};
struct EpiMoe1 {
    static constexpr bool PERM = true, HAS_MID = false, PRE = true;
    const int* list; const float* rs2; unsigned char* hb;
    __device__ __forceinline__ const void* pre_addr(const Unit& u, int tid) const { return rs2 + u.e * LIST_CAP + u.i0 + (tid & 255); }
    __device__ __forceinline__ void mid(f32x4 (&)[2][2][4][2], const Unit&, int, int, int, int) const {}
    __device__ __forceinline__ void operator()(const f32x4 (&acc)[2][2][4][2], const Unit& u, int wr, int wc, int fr, int fq, const PG8_LAS unsigned* pre) const {
        const int r0 = wr * 64 + fr, col0 = u.pn * 128 + wc * 32 + 8 * fq;
#pragma unroll
        for (int ai = 0; ai < 2; ++ai) { u32x2 w[4];
#pragma unroll
            for (int m = 0; m < 4; ++m) { const int r = r0 + ai * HALF + m * 16, i = u.i0 + r; float rs = 0.f;
                if (i < u.cnt) rs = __uint_as_float(pre[r]) * (1.f / WGU_SCALE);
                const float rsn = rs * -1.4426950408889634f;
#pragma unroll
                for (int n = 0; n < 2; ++n) { const f32x4 g = acc[ai][0][m][n] * rs, uu = acc[ai][1][m][n] * rs; f32x4 h;
#pragma unroll
                    for (int j = 0; j < 4; ++j) h[j] = g[j] * __builtin_amdgcn_rcpf(1.f + __builtin_amdgcn_exp2f(acc[ai][0][m][n][j] * rsn)) * uu[j];
                    w[m][n] = pk4_fp8(h[0], h[1], h[2], h[3]); } }
#pragma unroll
            for (int mp = 0; mp < 2; ++mp) { const u32x4 q = pair16(w[2 * mp], w[2 * mp + 1], fq);
                const int r = r0 + ai * HALF + (2 * mp + (fq & 1)) * 16;
                *(u32x4*)(hb + (size_t)(u.pm * 256 + r) * EFF + col0 - 8 * (fq & 1)) = q; } }
    }
};
struct MoeSched2 {
    const LAS_ int* tab; int G, c, nunits; const char* hb; const char* wdn;
    __device__ __forceinline__ bool next(int i, Unit& o) const {
        int L;
        if ((G & 7) == 0) {
            const int xcd = c & 7, slot = i * (G >> 3) + (c >> 3), q = nunits >> 3, r = nunits & 7;
            const int len = q + (xcd < r ? 1 : 0); if (slot >= len) return false;
            L = xcd * q + (xcd < r ? xcd : r) + slot;
        } else { L = i * G + c; if (L >= nunits) return false; }
        const int T = L >> 3; const int e = expert_of_tile(tab, T);
        o.pm = T; o.pn = L & 7; o.e = e; o.i0 = (T - tab[32 + e]) * 256; o.cnt = tab[e]; o.aux = 0; return true;
    }
    __device__ __forceinline__ const char* Aptr(const Unit& q) const { return hb + (size_t)q.pm * 256 * EFF; }
    __device__ __forceinline__ const char* Bptr(const Unit& q) const { return wdn + ((size_t)q.e * DM + (size_t)q.pn * 256) * EFF; }
    __device__ __forceinline__ unsigned rowoff(const Unit&, int) const { return 0u; }
};
struct EpiMoe2 {
    static constexpr bool PERM = true, HAS_MID = false, PRE = true;
    __device__ __forceinline__ const void* pre_addr(const Unit& u, int tid) const { const int i = u.e * LIST_CAP + u.i0 + (tid & 255); return tid < 256 ? (const void*)(list + i) : (const void*)(ew + i); }
    const int* list; const float* ew; unsigned char* yb;
    __device__ __forceinline__ void mid(f32x4 (&)[2][2][4][2], const Unit&, int, int, int, int) const {}
    __device__ __forceinline__ void operator()(const f32x4 (&acc)[2][2][4][2], const Unit& u, int wr, int wc, int fr, int fq, const PG8_LAS unsigned* pre) const {
        const int r0 = wr * 64 + fr, col0 = u.pn * 256 + wc * 32 + 8 * fq, odd = fq & 1;
#pragma unroll
        for (int ai = 0; ai < 2; ++ai)
#pragma unroll
            for (int mp = 0; mp < 2; ++mp) {
                float wv[2]; int slot[2];
#pragma unroll
                for (int q = 0; q < 2; ++q) { const int i = u.i0 + r0 + ai * HALF + (2 * mp + q) * 16; wv[q] = 0.f; slot[q] = -1;
                    if (i < u.cnt) { slot[q] = (int)pre[i - u.i0]; wv[q] = __uint_as_float(pre[256 + i - u.i0]) * (YB_SCALE / WDN_SCALE); } }
                const int myslot = odd ? slot[1] : slot[0];
#pragma unroll
                for (int bj = 0; bj < 2; ++bj) { u32x2 w8[2];
#pragma unroll
                    for (int q = 0; q < 2; ++q) { const f32x4 v0 = acc[ai][bj][2 * mp + q][0] * wv[q], v1 = acc[ai][bj][2 * mp + q][1] * wv[q];
                        w8[q].x = pk4_fp8(v0[0], v0[1], v0[2], v0[3]); w8[q].y = pk4_fp8(v1[0], v1[1], v1[2], v1[3]); }
                    const u32x4 q16 = pair16(w8[0], w8[1], fq);
                    if (myslot >= 0) *(u32x4*)(yb + (size_t)myslot * DM + col0 - 8 * odd + bj * HALF) = q16; } }
    }
};
}

#define LAS __attribute__((address_space(3)))
#define GAS __attribute__((address_space(1)))
constexpr int NWAVES = 8;
constexpr int RING_BYTES = 131072, LDS_BYTES = 147456, MISC_OFF = LDS_BYTES - 256, TAB_OFF = LDS_BYTES - 1024;
typedef unsigned v4u __attribute__((ext_vector_type(4)));
typedef float f32x2_hw __attribute__((ext_vector_type(2))); typedef __bf16 bf16x2_hw __attribute__((ext_vector_type(2)));
__device__ __forceinline__ unsigned pk2(float lo, float hi) { f32x2_hw v = {lo, hi}; bf16x2_hw b = __builtin_convertvector(v, bf16x2_hw); return __builtin_bit_cast(unsigned, b); }
#define LDS_WAIT() asm volatile("s_waitcnt lgkmcnt(0)" ::: "memory")

struct TrItem { const float* W; const float* gain; unsigned char* WT; int ldn, ldt, kb0, row0, k0, n0, fp8; float scale; };
struct TrRegs { pg8::f32x4 v[16]; float g[16]; };
__device__ __forceinline__ void tr_load(const TrItem& d, TrRegs& R, int lane) {
    const int kr = lane >> 4, nc = (lane & 15) * 4;
#pragma unroll
    for (int i = 0; i < 16; ++i) { R.v[i] = __builtin_nontemporal_load((const pg8::f32x4*)(d.W + (size_t)(d.k0 + kr + 4 * i) * d.ldn + d.n0 + nc)); R.g[i] = d.gain ? d.gain[d.k0 + kr + 4 * i] : 1.f; }
}
__device__ __forceinline__ void tr_store(const TrItem& d, const TrRegs& R, LAS float* scr, int lane) {
    const int kr = lane >> 4, nc = (lane & 15) * 4;
#pragma unroll
    for (int i = 0; i < 16; ++i) { const float g = R.g[i] * d.scale; LAS float* q = scr + (kr + 4 * i) * 65 + nc;
        q[0] = R.v[i].x * g; q[1] = R.v[i].y * g; q[2] = R.v[i].z * g; q[3] = R.v[i].w * g; }
    LDS_WAIT(); asm volatile("" ::: "memory");
    if (d.fp8) { const int c = lane & 3, nr = lane >> 2;
#pragma unroll
        for (int j = 0; j < 4; ++j) { const int n = nr + 16 * j; const LAS float* q = scr + (16 * c) * 65 + n;
            v4u o; o.x = pk4_fp8(q[0 * 65], q[1 * 65], q[2 * 65], q[3 * 65]); o.y = pk4_fp8(q[4 * 65], q[5 * 65], q[6 * 65], q[7 * 65]);
            o.z = pk4_fp8(q[8 * 65], q[9 * 65], q[10 * 65], q[11 * 65]); o.w = pk4_fp8(q[12 * 65], q[13 * 65], q[14 * 65], q[15 * 65]);
            *(v4u*)(d.WT + (size_t)(d.row0 + n) * d.ldt + d.kb0 + 16 * c) = o; } }
    else { const int c = lane & 7, nr = lane >> 3;
#pragma unroll
        for (int j = 0; j < 8; ++j) { const int n = nr + 8 * j; const LAS float* q = scr + (8 * c) * 65 + n;
            v4u o; o.x = pk2(q[0 * 65], q[1 * 65]); o.y = pk2(q[2 * 65], q[3 * 65]); o.z = pk2(q[4 * 65], q[5 * 65]); o.w = pk2(q[6 * 65], q[7 * 65]);
            *(v4u*)(d.WT + (size_t)(d.row0 + n) * d.ldt + d.kb0 + 16 * c) = o; } }
    LDS_WAIT(); asm volatile("" ::: "memory");
}

namespace mix {
typedef float f32x16 __attribute__((ext_vector_type(16)));
typedef float f32x4 __attribute__((ext_vector_type(4)));
typedef float f32x2 __attribute__((ext_vector_type(2)));
typedef short bf16x8 __attribute__((ext_vector_type(8)));
typedef short s16x4 __attribute__((ext_vector_type(4)));
typedef unsigned u32x4 __attribute__((ext_vector_type(4)));
typedef unsigned u32x2 __attribute__((ext_vector_type(2)));
typedef __bf16 bf16x2_t __attribute__((ext_vector_type(2)));
__device__ __forceinline__ unsigned cvtpk(float lo, float hi) { f32x2 v = {lo, hi}; bf16x2_t b = __builtin_convertvector(v, bf16x2_t); return __builtin_bit_cast(unsigned, b); }
__device__ __forceinline__ int crow(int r, int h) { return (r & 3) + 8 * (r >> 2) + 4 * h; }
#define MFMA32(a, b, c) __builtin_amdgcn_mfma_f32_32x32x16_bf16((a), (b), (c), 0, 0, 0)
#define MFMA16(a, b, c) __builtin_amdgcn_mfma_f32_16x16x32_bf16((a), (b), (c), 0, 0, 0)
#define ZERO16 (f32x16){0.f, 0.f, 0.f, 0.f, 0.f, 0.f, 0.f, 0.f, 0.f, 0.f, 0.f, 0.f, 0.f, 0.f, 0.f, 0.f}

constexpr int A_KP = 72, A_VP = 260;
constexpr int A_KS = 0, A_VT = 256 * A_KP * 2, A_BIAS = 139264, A_OST = A_VT + 64 * A_VP * 2;
constexpr float LOG2E = 1.4426950408889634f;
struct AttnKV { u32x4 kv[4], vv[4]; };
__device__ __forceinline__ void attn_kv_load(const Params& p, AttnKV& R, int unit, int tid) {
    const int b = unit >> 7, kvh = (unit >> 5) & 3, n = unit & 31;
    const bf16_t* KA = (const bf16_t*)(p.ws + WS_KA); const bf16_t* VA = (const bf16_t*)(p.ws + WS_VA);
    const int row = tid >> 1, half = tid & 1; const bool have = (n > 0) || (row >= 128);
    const size_t src = (size_t)(b * SEQ + (n - 1) * 128 + row) * 256 + kvh * 64 + half * 32;
#pragma unroll
    for (int c = 0; c < 4; ++c) { R.kv[c] = (u32x4){0u, 0u, 0u, 0u}; R.vv[c] = R.kv[c]; if (have) { R.kv[c] = *(const u32x4*)(KA + src + c * 8); R.vv[c] = *(const u32x4*)(VA + src + c * 8); } }
}
__device__ __forceinline__ void attn_bias_table(const Params& p, LAS unsigned char* lds, int kvh, int tid) {
    for (int q = tid; q < 768; q += 512) { const int gg = q / 192, dist = q % 192 - 32;
        ((LAS float*)(lds + A_BIAS))[q] = (dist >= 0 && dist < 128) ? p.rel_bias[T5B[dist & 127] * 16 + kvh * 4 + gg] * LOG2E : -INFINITY; }
}
__device__ __forceinline__ void attn_unit(const Params& p, LAS unsigned char* lds, int unit, int next_unit, AttnKV& KV, int tid, int lane, int wave, bool build_bias) {
    const int b = unit >> 7, kvh = (unit >> 5) & 3, n = unit & 31;
    const bf16_t* QA = (const bf16_t*)(p.ws + WS_QA);
    bf16_t* AR = (bf16_t*)((unsigned char*)p.out + 64 * MiB);
    const int g = wave >> 1, qh = wave & 1, head = kvh * 4 + g, r32 = lane & 31, h = lane >> 5;
    bf16x8 qf[4];
    { const int tok0 = b * SEQ + n * 128 + qh * 64;
#pragma unroll
      for (int ks = 0; ks < 4; ++ks) qf[ks] = *(const bf16x8*)(QA + (size_t)(tok0 + r32) * 1024 + head * 64 + 16 * ks + 8 * h); }
    __syncthreads();
    {
        const int row = tid >> 1, half = tid & 1;
#pragma unroll
        for (int c = 0; c < 4; ++c) *(LAS u32x4*)(lds + A_KS + row * (A_KP * 2) + half * 64 + c * 16) = KV.kv[c];
        LAS bf16_t* vt = (LAS bf16_t*)(lds + A_VT);
#pragma unroll
        for (int c = 0; c < 4; ++c)
#pragma unroll
            for (int e = 0; e < 4; ++e) { const unsigned w = KV.vv[c][e]; const int d = half * 32 + c * 8 + 2 * e; vt[d * A_VP + row] = (bf16_t)(w & 0xffffu); vt[(d + 1) * A_VP + row] = (bf16_t)(w >> 16); }
        if (build_bias) attn_bias_table(p, lds, kvh, tid);
    }
    __syncthreads();
    if (next_unit >= 0) attn_kv_load(p, KV, next_unit, tid);
    const float sink = p.sinks[head] * LOG2E;
    const LAS float* bext = (const LAS float*)(lds + A_BIAS) + g * 192 + (r32 - 4 * h + 32);
#pragma unroll 1
    for (int qt = 0; qt < 2; ++qt) {
        const int i0 = qh * 64 + qt * 32, jt0 = i0 >> 5;
        const int tok0 = b * SEQ + n * 128 + i0;
        f32x16 st[5];
#pragma unroll
        for (int jt = 0; jt < 5; ++jt) {
            st[jt] = ZERO16;
#pragma unroll
            for (int ks = 0; ks < 4; ++ks) { const bf16x8 a = *(const LAS bf16x8*)(lds + A_KS + ((jt0 + jt) * 32 + r32) * (A_KP * 2) + (16 * ks + 8 * h) * 2); st[jt] = MFMA32(a, qf[ks], st[jt]); }
        }
        if (qt == 0) {
#pragma unroll
            for (int ks = 0; ks < 4; ++ks) qf[ks] = *(const bf16x8*)(QA + (size_t)(tok0 + 32 + r32) * 1024 + head * 64 + 16 * ks + 8 * h); }
        float mx = sink;
#pragma unroll
        for (int jt = 0; jt < 5; ++jt) { const bool dead = (n == 0) && (jt0 + jt < 4);
#pragma unroll
            for (int r = 0; r < 16; ++r) { const float v = dead ? -INFINITY : st[jt][r] + bext[128 - 32 * jt - (r & 3) - 8 * (r >> 2)]; st[jt][r] = v; mx = fmaxf(mx, v); } }
        mx = fmaxf(mx, __shfl_xor(mx, 32));
        float sum = 0.f;
#pragma unroll
        for (int jt = 0; jt < 5; ++jt)
#pragma unroll
            for (int r = 0; r < 16; ++r) { const float e = __builtin_amdgcn_exp2f(st[jt][r] - mx); st[jt][r] = e; sum += e; }
        sum += __shfl_xor(sum, 32);
        const float inv = __builtin_amdgcn_rcpf(sum + __builtin_amdgcn_exp2f(sink - mx));
        f32x16 o[2];
        o[0] = ZERO16; o[1] = o[0];
#pragma unroll
        for (int jt = 0; jt < 5; ++jt)
#pragma unroll
            for (int s2 = 0; s2 < 2; ++s2) {
                u32x4 pw;
#pragma unroll
                for (int q = 0; q < 4; ++q) pw[q] = cvtpk(st[jt][8 * s2 + 2 * q] * inv, st[jt][8 * s2 + 2 * q + 1] * inv);
                const bf16x8 pa = __builtin_bit_cast(bf16x8, pw);
                const int key0 = (jt0 + jt) * 32 + 16 * s2 + 4 * h;
#pragma unroll
                for (int dt = 0; dt < 2; ++dt) { const LAS unsigned char* vp = lds + A_VT + ((dt * 32 + r32) * A_VP + key0) * 2;
                    const s16x4 lo = *(const LAS s16x4*)vp, hi = *(const LAS s16x4*)(vp + 16);
                    const bf16x8 vb = __builtin_shufflevector(lo, hi, 0, 1, 2, 3, 4, 5, 6, 7);
                    o[dt] = MFMA32(pa, vb, o[dt]); }
            }
        LAS bf16_t* stg = (LAS bf16_t*)(lds + A_OST + wave * 4096);
#pragma unroll
        for (int dt = 0; dt < 2; ++dt)
#pragma unroll
            for (int r = 0; r < 16; ++r) stg[crow(r, h) * 64 + dt * 32 + r32] = (bf16_t)(cvtpk(o[dt][r], 0.f) & 0xffffu);
        LDS_WAIT(); asm volatile("" ::: "memory");
#pragma unroll
        for (int i = 0; i < 4; ++i) { const int row = i * 8 + (lane >> 3), ch = lane & 7; const u32x4 v = *(const LAS u32x4*)(stg + row * 64 + ch * 8);
            *(u32x4*)(AR + (size_t)(tok0 + row) * 2048 + head * 64 + ch * 8) = v; }
        LDS_WAIT(); asm volatile("" ::: "memory");
    }
}

constexpr int H_SEGT2 = 138752;
constexpr int H_OB2 = 121344;
constexpr int H_QP = 0, H_KP = 17408, H_OB = 0, H_KT = 34816, H_VT = 53248, H_PB = 71680, H_ST = 80896, H_SEGT = 115712, H_EBM = 119808, H_EBL = 120320, H_EBD = 120832;
constexpr int HP128 = 272, HP64 = 144, HPO = 528;
struct HgChunkRegs { unsigned g[8]; unsigned q[8]; unsigned v[8]; };

template <bool FULL>
__device__ __forceinline__ void hg_load(const Params& p, HgChunkRegs& R, int tokc, int hh, int lane, int wave) {
    const unsigned short* GH = (const unsigned short*)(p.ws + WS_GH); const bf16_t* QH = (const bf16_t*)(p.ws + WS_QH); const bf16_t* IH = (const bf16_t*)(p.ws + WS_IH);
#pragma unroll
    for (int i = 0; i < 8; ++i) { const size_t o = (size_t)(tokc + 8 * wave + i) * 1024 + hh * 128 + 2 * lane;
        R.g[i] = *(const unsigned*)(GH + o); R.v[i] = *(const unsigned*)(IH + o); if (FULL) R.q[i] = *(const unsigned*)(QH + o); else R.q[i] = 0u; }
}

template <bool FULL>
__device__ __forceinline__ void hg_chunk(const Params& p, LAS unsigned char* lds, HgChunkRegs& R, f32x16 (&S)[2], f32x2& dlog, int tokc, int tokn, int hh, int tid, int lane, int wave, int par) {
    const int r32 = lane & 31, h = lane >> 5;
    f32x2 gg[8];
#pragma unroll
    for (int i = 0; i < 8; ++i) gg[i] = (f32x2){h16_lo(R.g[i]), h16_hi(R.g[i])};
    f32x2 c[8]; c[0] = gg[0];
#pragma unroll
    for (int i = 1; i < 8; ++i) c[i] = c[i - 1] + gg[i];
    const int segt = par ? H_SEGT2 : H_SEGT;
    f32x2 pre = {0.f, 0.f}, bm = {0.f, 0.f}, bl = {0.f, 0.f};
#pragma unroll
    for (int w = 0; w < 8; ++w) { const f32x2 t = *(const LAS f32x2*)(lds + segt + w * 512 + lane * 8); if (w < wave) pre += t; if (w < 4) bm += t; bl += t; }
    {
        unsigned kt0[4], kt1[4], vt0[4], vt1[4];
#pragma unroll
        for (int i = 0; i < 8; ++i) {
            const f32x2 bb = c[i] + pre;
            const float e2x = __builtin_amdgcn_exp2f(bm.x - bb.x), e2y = __builtin_amdgcn_exp2f(bm.y - bb.y);
            const float kx = (1.f - __builtin_amdgcn_exp2f(gg[i].x)) * e2x, ky = (1.f - __builtin_amdgcn_exp2f(gg[i].y)) * e2y;
            const int t = 8 * wave + i;
            if (FULL) { const float e1x = __builtin_amdgcn_exp2f(bb.x - bm.x), e1y = __builtin_amdgcn_exp2f(bb.y - bm.y);
                const float qx = __uint_as_float(R.q[i] << 16) * e1x, qy = __uint_as_float(R.q[i] & 0xffff0000u) * e1y;
                *(LAS unsigned*)(lds + H_QP + t * HP128 + lane * 4) = cvtpk(qx, qy);
                *(LAS unsigned*)(lds + H_KP + t * HP128 + lane * 4) = cvtpk(kx, ky); }
            const unsigned kxb = cvtpk(kx, 0.f) & 0xffffu, kyb = cvtpk(ky, 0.f) & 0xffffu;
            const unsigned vx = R.v[i] & 0xffffu, vy = R.v[i] >> 16;
            if (i & 1) { kt0[i >> 1] |= kxb << 16; kt1[i >> 1] |= kyb << 16; vt0[i >> 1] |= vx << 16; vt1[i >> 1] |= vy << 16; }
            else { kt0[i >> 1] = kxb; kt1[i >> 1] = kyb; vt0[i >> 1] = vx; vt1[i >> 1] = vy; }
        }
        *(LAS u32x4*)(lds + H_KT + (2 * lane) * HP64 + wave * 16) = (u32x4){kt0[0], kt0[1], kt0[2], kt0[3]};
        *(LAS u32x4*)(lds + H_KT + (2 * lane + 1) * HP64 + wave * 16) = (u32x4){kt1[0], kt1[1], kt1[2], kt1[3]};
        *(LAS u32x4*)(lds + H_VT + (2 * lane) * HP64 + wave * 16) = (u32x4){vt0[0], vt0[1], vt0[2], vt0[3]};
        *(LAS u32x4*)(lds + H_VT + (2 * lane + 1) * HP64 + wave * 16) = (u32x4){vt1[0], vt1[1], vt1[2], vt1[3]};
        if (wave == 0) {
            *(LAS f32x2*)(lds + H_EBM + lane * 8) = (f32x2){__builtin_amdgcn_exp2f(bm.x), __builtin_amdgcn_exp2f(bm.y)};
            *(LAS f32x2*)(lds + H_EBL + lane * 8) = (f32x2){__builtin_amdgcn_exp2f(bl.x), __builtin_amdgcn_exp2f(bl.y)};
            *(LAS f32x2*)(lds + H_EBD + lane * 8) = (f32x2){__builtin_amdgcn_exp2f(bl.x - bm.x), __builtin_amdgcn_exp2f(bl.y - bm.y)};
            dlog += bl;
        }
    }
    __syncthreads();
    if (tokn >= 0) hg_load<FULL>(p, R, tokn, hh, lane, wave);
    const int vt = wave >> 1, ktb = 2 * (wave & 1);
    int kvec = (ktb * 32 + 4 * h) * 4; asm volatile("" : "+v"(kvec));
    f32x16 o; u32x4 g0, g1;
    if (FULL) {
        int stw = (vt * 32 + r32) * HP128 + (ktb * 32 + 4 * h) * 2; asm volatile("" : "+v"(stw));
#pragma unroll
        for (int i = 0; i < 2; ++i)
#pragma unroll
            for (int q = 0; q < 4; ++q) { const f32x4 e = *(const LAS f32x4*)(lds + H_EBM + kvec + (i * 32 + 8 * q) * 4);
                u32x2 w; w.x = cvtpk(S[i][4 * q] * e.x, S[i][4 * q + 1] * e.y); w.y = cvtpk(S[i][4 * q + 2] * e.z, S[i][4 * q + 3] * e.w);
                *(LAS u32x2*)(lds + H_ST + stw + (i * 32 + 8 * q) * 2) = w; }
        const int ti = wave >> 1, l15 = lane & 15, l4 = lane >> 4;
#pragma unroll
        for (int i = 0; i < 2; ++i) { const int si = 2 * (wave & 1) + i; f32x4 a4 = {0.f, 0.f, 0.f, 0.f};
#pragma unroll
            for (int ks = 0; ks < 4; ++ks) { const bf16x8 a = *(const LAS bf16x8*)(lds + H_QP + (16 * ti + l15) * HP128 + (32 * ks + 8 * l4) * 2);
                const bf16x8 bq = *(const LAS bf16x8*)(lds + H_KP + (16 * si + l15) * HP128 + (32 * ks + 8 * l4) * 2); a4 = MFMA16(a, bq, a4); }
            const int sidx = 16 * si + l15;
#pragma unroll
            for (int r = 0; r < 4; ++r) { const int t = 16 * ti + 4 * l4 + r; const float v = (sidx <= t) ? a4[r] : 0.f; *(LAS bf16_t*)(lds + H_PB + t * HP64 + sidx * 2) = (bf16_t)(cvtpk(v, 0.f) & 0xffffu); } }
        __syncthreads();
        const int tt = wave & 1; o = ZERO16;
        { const bf16_t* gop = (const bf16_t*)(p.ws + WS_GO) + (size_t)(tokc + (tid >> 3)) * 1024 + hh * 128 + 16 * (tid & 7); g0 = *(const u32x4*)gop; g1 = *(const u32x4*)(gop + 8); }
#pragma unroll
        for (int ks = 0; ks < 4; ++ks) { const bf16x8 a = *(const LAS bf16x8*)(lds + H_PB + (32 * tt + r32) * HP64 + (16 * ks + 8 * h) * 2);
            const bf16x8 bv = *(const LAS bf16x8*)(lds + H_VT + (32 * vt + r32) * HP64 + (16 * ks + 8 * h) * 2); o = MFMA32(a, bv, o); }
#pragma unroll
        for (int ks = 0; ks < 8; ++ks) { const bf16x8 a = *(const LAS bf16x8*)(lds + H_QP + (32 * tt + r32) * HP128 + (16 * ks + 8 * h) * 2);
            const bf16x8 bs = *(const LAS bf16x8*)(lds + H_ST + (32 * vt + r32) * HP128 + (16 * ks + 8 * h) * 2); o = MFMA32(a, bs, o); }
#pragma unroll
        for (int r = 0; r < 16; ++r) *(LAS bf16_t*)(lds + H_OB2 + (32 * tt + crow(r, h)) * HP128 + (32 * vt + r32) * 2) = (bf16_t)(cvtpk(o[r], 0.f) & 0xffffu);
    }
#pragma unroll
    for (int i = 0; i < 2; ++i) { f32x16 u = ZERO16;
#pragma unroll
        for (int ks = 0; ks < 4; ++ks) { const bf16x8 a = *(const LAS bf16x8*)(lds + H_KT + ((ktb + i) * 32 + r32) * HP64 + (16 * ks + 8 * h) * 2);
            const bf16x8 bv = *(const LAS bf16x8*)(lds + H_VT + (32 * vt + r32) * HP64 + (16 * ks + 8 * h) * 2); u = MFMA32(a, bv, u); }
#pragma unroll
        for (int q = 0; q < 4; ++q) { const f32x4 el = *(const LAS f32x4*)(lds + H_EBL + kvec + (i * 32 + 8 * q) * 4), ed = *(const LAS f32x4*)(lds + H_EBD + kvec + (i * 32 + 8 * q) * 4);
#pragma unroll
            for (int j = 0; j < 4; ++j) S[i][4 * q + j] = S[i][4 * q + j] * el[j] + u[4 * q + j] * ed[j]; } }
    if (FULL) {
        if (tokn >= 0) {
            f32x2 tn = {0.f, 0.f};
#pragma unroll
            for (int i = 0; i < 8; ++i) tn += (f32x2){h16_lo(R.g[i]), h16_hi(R.g[i])};
            *(LAS f32x2*)(lds + (par ? H_SEGT : H_SEGT2) + wave * 512 + lane * 8) = tn; }
        __syncthreads();
        const int t = tid >> 3, part = tid & 7; f32x4 ov[4]; float ss = 0.f;
        { const u32x4 w0 = *(const LAS u32x4*)(lds + H_OB2 + t * HP128 + part * 32), w1 = *(const LAS u32x4*)(lds + H_OB2 + t * HP128 + part * 32 + 16);
          const unsigned ww[8] = {w0.x, w0.y, w0.z, w0.w, w1.x, w1.y, w1.z, w1.w};
#pragma unroll
          for (int q = 0; q < 4; ++q) { ov[q] = (f32x4){__uint_as_float(ww[2 * q] << 16), __uint_as_float(ww[2 * q] & 0xffff0000u), __uint_as_float(ww[2 * q + 1] << 16), __uint_as_float(ww[2 * q + 1] & 0xffff0000u)};
              ss += (ov[q].x * ov[q].x + ov[q].y * ov[q].y) + (ov[q].z * ov[q].z + ov[q].w * ov[q].w); } }
        ss += __shfl_xor(ss, 1); ss += __shfl_xor(ss, 2); ss += __shfl_xor(ss, 4);
        const float rstd = __builtin_amdgcn_rsqf(ss * (1.f / 128.f) + EPS);
        const size_t tok = (size_t)(tokc + t);
        unsigned gw[8] = {g0.x, g0.y, g0.z, g0.w, g1.x, g1.y, g1.z, g1.w}, ow[8];
#pragma unroll
        for (int q = 0; q < 4; ++q) { const f32x4 gn = *(const f32x4*)(p.hg_norm_g + 16 * part + 4 * q);
            const unsigned ga = gw[2 * q], gb = gw[2 * q + 1];
            const float z0 = __uint_as_float(ga << 16), z1 = __uint_as_float(ga & 0xffff0000u), z2 = __uint_as_float(gb << 16), z3 = __uint_as_float(gb & 0xffff0000u);
            const float y0 = ov[q].x * rstd * gn.x * (z0 * pg8::sigm(z0)), y1 = ov[q].y * rstd * gn.y * (z1 * pg8::sigm(z1)), y2 = ov[q].z * rstd * gn.z * (z2 * pg8::sigm(z2)), y3 = ov[q].w * rstd * gn.w * (z3 * pg8::sigm(z3));
            ow[2 * q] = cvtpk(y0, y1); ow[2 * q + 1] = cvtpk(y2, y3); }
        bf16_t* AR = (bf16_t*)((unsigned char*)p.out + 64 * MiB) + tok * 2048 + 1024 + hh * 128 + 16 * part;
        *(u32x4*)AR = (u32x4){ow[0], ow[1], ow[2], ow[3]}; *(u32x4*)(AR + 8) = (u32x4){ow[4], ow[5], ow[6], ow[7]};
    }
}

constexpr int CW_CNT = 8192;
constexpr int CW_P5 = 2560;
constexpr int CW_HG = 256;
constexpr size_t WS_HD = WS_HST + 16 * MiB;
constexpr int HA_KT0 = 0, HA_VT0 = 18432, HA_BUF = 36864;
struct HgARegs { unsigned g[8]; unsigned v[8]; };
__device__ __forceinline__ void hgA_load(const Params& p, HgARegs& R, int tokc, int hh, int lane, int wave) {
    const unsigned short* GH = (const unsigned short*)(p.ws + WS_GH); const bf16_t* IH = (const bf16_t*)(p.ws + WS_IH);
    const int tg = lane >> 3, kp = lane & 7;
#pragma unroll
    for (int i = 0; i < 8; ++i) { const size_t o = (size_t)(tokc + 8 * tg + i) * 1024 + hh * 128 + 16 * wave + 2 * kp; R.g[i] = *(const unsigned*)(GH + o); R.v[i] = *(const unsigned*)(IH + o); }
}
__device__ __forceinline__ void hg_passA(const Params& p, LAS unsigned char* lds, int unit, int tid, int lane, int wave) {
    const int bh = unit >> 3, seg = unit & 7, b = bh >> 3, hh = bh & 7; const int tok0 = b * SEQ + seg * 512;
    const int r32 = lane & 31, h = lane >> 5, vt = wave >> 1, ktb = 2 * (wave & 1), tg = lane >> 3, kp = lane & 7;
    f32x16 S[2]; S[0] = ZERO16; S[1] = S[0];
    f32x2 carry = {0.f, 0.f};
    HgARegs Ra, Rb; hgA_load(p, Ra, tok0 + 64 * 7, hh, lane, wave); hgA_load(p, Rb, tok0 + 64 * 6, hh, lane, wave);
    __syncthreads();
    auto chunk = [&](HgARegs& R, const int c) {
        const int pb = (c & 1) * HA_BUF;
        f32x2 gg[8];
#pragma unroll
        for (int i = 0; i < 8; ++i) gg[i] = (f32x2){h16_lo(R.g[i]), h16_hi(R.g[i])};
        f32x2 suf[8]; suf[7] = (f32x2){0.f, 0.f};
#pragma unroll
        for (int i = 6; i >= 0; --i) suf[i] = suf[i + 1] + gg[i + 1];
        const f32x2 tot = suf[0] + gg[0];
        f32x2 x = tot;
        { f32x2 y; y.x = __shfl(x.x, lane + 8); y.y = __shfl(x.y, lane + 8); if (tg < 7) x += y; }
        { f32x2 y; y.x = __shfl(x.x, lane + 16); y.y = __shfl(x.y, lane + 16); if (tg < 6) x += y; }
        { f32x2 y; y.x = __shfl(x.x, lane + 32); y.y = __shfl(x.y, lane + 32); if (tg < 4) x += y; }
        const f32x2 gsuf = x - tot + carry;
        f32x2 ctot; ctot.x = __shfl(x.x, kp); ctot.y = __shfl(x.y, kp);
        unsigned kt0[4], kt1[4], vt0[4], vt1[4];
#pragma unroll
        for (int i = 0; i < 8; ++i) {
            const float kx = (1.f - __builtin_amdgcn_exp2f(gg[i].x)) * __builtin_amdgcn_exp2f(gsuf.x + suf[i].x), ky = (1.f - __builtin_amdgcn_exp2f(gg[i].y)) * __builtin_amdgcn_exp2f(gsuf.y + suf[i].y);
            const unsigned kxb = cvtpk(kx, 0.f) & 0xffffu, kyb = cvtpk(ky, 0.f) & 0xffffu, vx = R.v[i] & 0xffffu, vy = R.v[i] >> 16;
            if (i & 1) { kt0[i >> 1] |= kxb << 16; kt1[i >> 1] |= kyb << 16; vt0[i >> 1] |= vx << 16; vt1[i >> 1] |= vy << 16; }
            else { kt0[i >> 1] = kxb; kt1[i >> 1] = kyb; vt0[i >> 1] = vx; vt1[i >> 1] = vy; }
        }
        const int krow = 16 * wave + 2 * kp;
        *(LAS u32x4*)(lds + pb + HA_KT0 + krow * HP64 + tg * 16) = (u32x4){kt0[0], kt0[1], kt0[2], kt0[3]};
        *(LAS u32x4*)(lds + pb + HA_KT0 + (krow + 1) * HP64 + tg * 16) = (u32x4){kt1[0], kt1[1], kt1[2], kt1[3]};
        *(LAS u32x4*)(lds + pb + HA_VT0 + krow * HP64 + tg * 16) = (u32x4){vt0[0], vt0[1], vt0[2], vt0[3]};
        *(LAS u32x4*)(lds + pb + HA_VT0 + (krow + 1) * HP64 + tg * 16) = (u32x4){vt1[0], vt1[1], vt1[2], vt1[3]};
        carry += ctot;
        if (c > 1) hgA_load(p, R, tok0 + 64 * (c - 2), hh, lane, wave);
        __syncthreads();
#pragma unroll
        for (int i = 0; i < 2; ++i)
#pragma unroll
            for (int ks = 0; ks < 4; ++ks) { const bf16x8 a = *(const LAS bf16x8*)(lds + pb + HA_KT0 + ((ktb + i) * 32 + r32) * HP64 + (16 * ks + 8 * h) * 2);
                const bf16x8 bv = *(const LAS bf16x8*)(lds + pb + HA_VT0 + (32 * vt + r32) * HP64 + (16 * ks + 8 * h) * 2); S[i] = MFMA32(a, bv, S[i]); }
    };
#pragma unroll 1
    for (int c = 7; c >= 1; c -= 2) { chunk(Ra, c); chunk(Rb, c - 1); }
    float* hst = (float*)(p.ws + WS_HST) + (size_t)unit * 16384;
#pragma unroll
    for (int i = 0; i < 2; ++i)
#pragma unroll
        for (int r = 0; r < 16; ++r) hst[(wave * 32 + i * 16 + r) * 64 + lane] = S[i][r];
    if (tg == 0) *(f32x2*)((float*)(p.ws + WS_HD) + unit * 128 + 16 * wave + 2 * kp) = carry;
    asm volatile("s_waitcnt vmcnt(0)" ::: "memory");
    __syncthreads();
    if (tid == 0) { __builtin_amdgcn_fence(__ATOMIC_RELEASE, "agent"); asm volatile("s_waitcnt vmcnt(0)" ::: "memory");
        __hip_atomic_fetch_add((unsigned*)(p.ws + WS_CTL) + CW_HG + 64 * bh, 1u, __ATOMIC_RELAXED, __HIP_MEMORY_SCOPE_AGENT); }
}
__device__ __forceinline__ void hg_passC(const Params& p, LAS unsigned char* lds, int unit, int tid, int lane, int wave) {
    const int bh = unit >> 3, seg = unit & 7, b = bh >> 3, hh = bh & 7; const int tok0 = b * SEQ + seg * 512;
    const int h = lane >> 5, ktb = 2 * (wave & 1);
    int kvec = (ktb * 32 + 4 * h) * 4; asm volatile("" : "+v"(kvec));
    f32x16 S[2]; S[0] = ZERO16; S[1] = S[0];
    if (tid == 0) {
        unsigned* cw = (unsigned*)(p.ws + WS_CTL) + CW_HG + 64 * bh; unsigned sp = 0u;
        while (__hip_atomic_load(cw, __ATOMIC_RELAXED, __HIP_MEMORY_SCOPE_AGENT) < 8u) { __builtin_amdgcn_s_sleep(2); if (++sp > (1u << 22)) break; }
        __builtin_amdgcn_fence(__ATOMIC_ACQUIRE, "agent"); asm volatile("s_waitcnt vmcnt(0)" ::: "memory"); }
    __syncthreads();
    { int t3 = threadIdx.x; asm volatile("" : "+v"(t3));
      if (t3 < 128) { float a = 0.f;
        for (int i = seg - 1; i >= 0; --i) { ((LAS float*)(lds + H_ST))[i * 128 + t3] = __builtin_amdgcn_exp2f(a); a += ((const float*)(p.ws + WS_HD))[(bh * 8 + i) * 128 + t3]; } } }
    __syncthreads();
    if (seg > 0) {
        float cur[32];
        { const float* hst = (const float*)(p.ws + WS_HST) + (size_t)(bh * 8) * 16384;
#pragma unroll
          for (int r = 0; r < 32; ++r) cur[r] = hst[(wave * 32 + r) * 64 + lane]; }
#pragma unroll 1
        for (int i = 0; i < seg; ++i) {
            float nx[32];
            const float* hst = (const float*)(p.ws + WS_HST) + (size_t)(bh * 8 + ((i + 1 < seg) ? i + 1 : i)) * 16384;
#pragma unroll
            for (int r = 0; r < 32; ++r) nx[r] = hst[(wave * 32 + r) * 64 + lane];
#pragma unroll
            for (int t2 = 0; t2 < 2; ++t2)
#pragma unroll
                for (int q = 0; q < 4; ++q) { const f32x4 e = *(const LAS f32x4*)(lds + H_ST + i * 512 + kvec + (t2 * 32 + 8 * q) * 4);
#pragma unroll
                    for (int j = 0; j < 4; ++j) S[t2][4 * q + j] += e[j] * cur[t2 * 16 + 4 * q + j]; }
#pragma unroll
            for (int r = 0; r < 32; ++r) cur[r] = nx[r];
        }
    }
    HgChunkRegs R; hg_load<true>(p, R, tok0, hh, lane, wave);
    f32x2 dlog = {0.f, 0.f};
    { f32x2 t0 = {0.f, 0.f};
#pragma unroll
      for (int i = 0; i < 8; ++i) t0 += (f32x2){h16_lo(R.g[i]), h16_hi(R.g[i])};
      *(LAS f32x2*)(lds + H_SEGT + wave * 512 + lane * 8) = t0; }
    __syncthreads();
#pragma unroll 1
    for (int c = 0; c < 8; ++c) {
        hg_chunk<true>(p, lds, R, S, dlog, tok0 + 64 * c, (c < 7) ? tok0 + 64 * (c + 1) : -1, hh, tid, lane, wave, c & 1);
    }
    __syncthreads();
}
}

namespace rt {
using namespace mix;
constexpr int XP = 1040;
constexpr int R_XH = 0, R_XL = 64 * XP, R_RED = 0, R_SS = 2 * 64 * XP;
__device__ __forceinline__ void router_unit(const Params& p, LAS unsigned char* lds, int unit, int tid, int lane, int wave, bool commit) {
    const int r0 = unit * 64, r32 = lane & 31, h = lane >> 5;
    const bf16_t* XB2 = (const bf16_t*)(p.ws + WS_XB2);
    const bf16_t* WRH = (const bf16_t*)(p.ws + WS_WRH); const bf16_t* WRL = (const bf16_t*)(p.ws + WS_WRL);
    const int tile = wave & 3, rtile = tile >> 1, nt = tile & 1, kh = wave >> 2;
    f32x16 acc = ZERO16;
    u32x4 xr[8];
#pragma unroll
    for (int i = 0; i < 8; ++i) xr[i] = *(const u32x4*)(XB2 + (size_t)(r0 + 8 * wave + i) * DM + 8 * lane);
    bf16x8 wh[2][4], wl[2][4];
#define RT_WLOAD(buf, it) do { _Pragma("unroll") for (int ks = 0; ks < 4; ++ks) { const size_t o = (size_t)(32 * nt + r32) * DM + 512 * ((it) >> 2) + 256 * kh + 64 * ((it) & 3) + 16 * ks + 8 * h; \
        wh[buf][ks] = *(const bf16x8*)(WRH + o); wl[buf][ks] = *(const bf16x8*)(WRL + o); } } while (0)
    RT_WLOAD(0, 0);
#define RT_MMA(buf, kg) do { _Pragma("unroll") for (int ks = 0; ks < 4; ++ks) { const int ko = (256 * kh + 64 * (kg) + 16 * ks + 8 * h) * 2; \
        const bf16x8 ah = *(const LAS bf16x8*)(lds + R_XH + (32 * rtile + r32) * XP + ko); \
        acc = MFMA32(ah, wh[buf][ks], acc); acc = MFMA32(ah, wl[buf][ks], acc); } } while (0)
#pragma unroll 1
    for (int sl = 0; sl < 4; ++sl) {
        __syncthreads();
#pragma unroll
        for (int i = 0; i < 8; ++i) *(LAS u32x4*)(lds + R_XH + (8 * wave + i) * XP + lane * 16) = xr[i];
        if (sl < 3) {
#pragma unroll
            for (int i = 0; i < 8; ++i) xr[i] = *(const u32x4*)(XB2 + (size_t)(r0 + 8 * wave + i) * DM + 512 * (sl + 1) + 8 * lane); }
        __syncthreads();
        RT_WLOAD(1, 4 * sl + 1); RT_MMA(0, 0);
        RT_WLOAD(0, 4 * sl + 2); RT_MMA(1, 1);
        RT_WLOAD(1, 4 * sl + 3); RT_MMA(0, 2);
        if (sl < 3) RT_WLOAD(0, 4 * sl + 4);
        RT_MMA(1, 3);
    }
#undef RT_MMA
#undef RT_WLOAD
    __syncthreads();
#pragma unroll
    for (int r = 0; r < 16; ++r) *(LAS float*)(lds + R_RED + ((kh * 64 + 32 * rtile + crow(r, h)) * 65 + 32 * nt + r32) * 4) = acc[r];
    __syncthreads();
    if (tid < 64) {
        const int r = r0 + tid; float ss = 0.f;
        { const f32x4* sp = (const f32x4*)((const float*)(p.ws + WS_SS2P) + (size_t)r * 32);
#pragma unroll
          for (int q = 0; q < 8; ++q) { const f32x4 t = sp[q]; ss += (t.x + t.y) + (t.z + t.w); } }
        const float rstd = 1.f / sqrtf(ss * (1.f / DM) + EPS);
        ((float*)(p.ws + WS_RS2))[r] = rstd;
        float lg[36];
#pragma unroll
        for (int e = 0; e < 36; ++e) lg[e] = *(const LAS float*)(lds + R_RED + (tid * 65 + e) * 4) + *(const LAS float*)(lds + R_RED + ((64 + tid) * 65 + e) * 4);
        float gl[4]; int gi = 0;
#pragma unroll
        for (int e = 0; e < 4; ++e) gl[e] = lg[e] * rstd + p.b_gr[e];
        float gm = gl[0];
#pragma unroll
        for (int e = 1; e < 4; ++e) if (gl[e] > gm) { gm = gl[e]; gi = e; }
        float gs = 0.f;
#pragma unroll
        for (int e = 0; e < 4; ++e) gs += __expf(gl[e] - gm);
        const float gw_ = 1.f / gs;
        float el[8];
#pragma unroll
        for (int e = 0; e < 8; ++e) { float v = 0.f;
#pragma unroll
            for (int g = 0; g < 4; ++g) v = (g == gi) ? lg[4 + g * 8 + e] : v;
            el[e] = v * rstd + p.b_er[gi * 8 + e]; }
        int i1 = 0; float m1 = el[0];
#pragma unroll
        for (int e = 1; e < 8; ++e) if (el[e] > m1) { m1 = el[e]; i1 = e; }
        int i2 = -1; float m2 = -3.0e38f;
#pragma unroll
        for (int e = 0; e < 8; ++e) if (e != i1 && el[e] > m2) { m2 = el[e]; i2 = e; }
        const float p2 = __expf(m2 - m1);
        const float w1 = gw_ / (1.f + p2), w2 = gw_ * p2 / (1.f + p2);
        const int e1 = gi * 8 + i1, e2 = gi * 8 + i2;
        int* EID = (int*)(p.ws + WS_EID); float* EW = (float*)(p.ws + WS_EW); int* CNT = (int*)(p.ws + WS_CTL); int* LIST = (int*)(p.ws + WS_LIST);
        EID[2 * r] = e1; EID[2 * r + 1] = e2; EW[2 * r] = w1; EW[2 * r + 1] = w2;
        float* LW = (float*)(p.ws + WS_LISTW); float* LR = (float*)(p.ws + WS_LISTR);
        LAS int* lcnt = (LAS int*)(lds + 36864); LAS int* gbase = lcnt + 32;
        if (tid < 32) lcnt[tid] = 0;
        asm volatile("s_waitcnt lgkmcnt(0)" ::: "memory");
        const int lr1 = __hip_atomic_fetch_add(lcnt + e1, 1, __ATOMIC_RELAXED, __HIP_MEMORY_SCOPE_WORKGROUP);
        const int lr2 = __hip_atomic_fetch_add(lcnt + e2, 1, __ATOMIC_RELAXED, __HIP_MEMORY_SCOPE_WORKGROUP);
        asm volatile("s_waitcnt lgkmcnt(0)" ::: "memory");
        if (tid < 32) { const int c = lcnt[tid]; gbase[tid] = (commit && c > 0) ? atomicAdd(&CNT[CW_CNT + 32 * tid], c) : 0; }
        asm volatile("s_waitcnt vmcnt(0) lgkmcnt(0)" ::: "memory");
        if (commit) { const int q1 = gbase[e1] + lr1; LIST[e1 * LIST_CAP + q1] = 2 * r; LW[e1 * LIST_CAP + q1] = w1; LR[e1 * LIST_CAP + q1] = rstd;
        const int q2 = gbase[e2] + lr2; LIST[e2 * LIST_CAP + q2] = 2 * r + 1; LW[e2 * LIST_CAP + q2] = w2; LR[e2 * LIST_CAP + q2] = rstd; }
    }
}
}

#define XB_TMO      128
#define XB_XCNT(j)  (256  + 64 * (j))
#define XB_XSUB(j)  (1280 + 64 * (j))
#define XB_XGEN(j)  (2304 + 64 * (j))
#define XB_TOP      3328
#define XB_TOPGEN   3392
#define XCD_BAR_WORDS 3456
#define XB_SPIN_CAP (1u << 22)
__device__ __forceinline__ unsigned xb_ld(unsigned* p)              { return __hip_atomic_load(p, __ATOMIC_RELAXED, __HIP_MEMORY_SCOPE_AGENT); }
__device__ __forceinline__ unsigned xb_add(unsigned* p, unsigned v) { return __hip_atomic_fetch_add(p, v, __ATOMIC_RELAXED, __HIP_MEMORY_SCOPE_AGENT); }
__device__ __forceinline__ unsigned xb_xcc_id() { return (unsigned)__builtin_amdgcn_s_getreg((3 << 11) | 20) & 0xFu; }
#define XB_SPIN(cond, bar) do { unsigned _sp = 0; while (cond) { __builtin_amdgcn_s_sleep(1); \
    if ((++_sp & 255u) == 0u) { if (xb_ld(&(bar)[XB_TMO])) break; if (_sp > XB_SPIN_CAP) { atomicAdd(&(bar)[XB_TMO], 1u); break; } } } } while (0)
struct XcdBarrier { unsigned* bar; unsigned x; volatile LAS unsigned* st; };
__device__ __forceinline__ XcdBarrier xcd_barrier_post(unsigned* bar, volatile LAS unsigned* st) {
    XcdBarrier b; b.bar = bar; b.x = xb_xcc_id(); b.st = st;
    if (threadIdx.x == 0) (void)xb_add(&bar[XB_XCNT(b.x)], 1u);
    return b;
}
__device__ __forceinline__ void xcd_barrier_complete(unsigned* bar, unsigned x, unsigned& nloc, unsigned& nx) {
    const unsigned G = gridDim.x * gridDim.y * gridDim.z;
    unsigned sum, cnt, mine, sp = 0u;
    for (;;) {
        sum = 0u; cnt = 0u; mine = 0u;
#pragma unroll
        for (unsigned j = 0; j < 16; ++j) { const unsigned c = xb_ld(&bar[XB_XCNT(j)]); sum += c; cnt += (c > 0u) ? 1u : 0u; mine = (j == x) ? c : mine; }
        if (sum == G) break;
        __builtin_amdgcn_s_sleep(1);
        if ((++sp & 255u) == 0u) { if (xb_ld(&bar[XB_TMO])) break; if (sp > XB_SPIN_CAP) { atomicAdd(&bar[XB_TMO], 1u); break; } }
    }
    nloc = mine > 0u ? mine : 1u; nx = cnt > 0u ? cnt : 1u;
}
__device__ __forceinline__ void xcd_barrier(const XcdBarrier& b) {
    asm volatile("s_waitcnt vmcnt(0)" ::: "memory");
    __syncthreads();
    if (threadIdx.x == 0) {
        unsigned* bar = b.bar;
        __builtin_amdgcn_s_waitcnt(0);
        unsigned nloc = b.st[0], nx = b.st[1];
        if (nloc == 0u) { xcd_barrier_complete(bar, b.x, nloc, nx); b.st[0] = nloc; b.st[1] = nx; }
        const unsigned old = xb_add(&bar[XB_XSUB(b.x)], 1u);
        const unsigned gen = old / nloc;
        if (old + 1u == (gen + 1u) * nloc) {
            __builtin_amdgcn_fence(__ATOMIC_RELEASE, "agent");
            asm volatile("s_waitcnt vmcnt(0)" ::: "memory");
            const unsigned og = xb_add(&bar[XB_TOP], 1u);
            const unsigned tg = og / nx;
            if (og + 1u == (tg + 1u) * nx) xb_add(&bar[XB_TOPGEN], 1u);
            else XB_SPIN(xb_ld(&bar[XB_TOPGEN]) == tg, bar);
            __builtin_amdgcn_fence(__ATOMIC_ACQUIRE, "agent");
            xb_add(&bar[XB_XGEN(b.x)], 1u);
            asm volatile("s_waitcnt vmcnt(0)" ::: "memory");
        } else {
            XB_SPIN(xb_ld(&bar[XB_XGEN(b.x)]) == gen, bar);
            __builtin_amdgcn_fence(__ATOMIC_ACQUIRE, "agent");
            asm volatile("s_waitcnt vmcnt(0)" ::: "memory");
        }
    }
    __syncthreads();
}
constexpr int CW_BAR = 4096;

constexpr int WGM_G1 = 4, WGM_G18 = 4, WGM_P4 = 8, WGM_P5 = 8;
constexpr int REP_MASK = 0;
#define REPEAT(k) for (int rep_ = 0; rep_ <= ((REP_MASK >> (k)) & 1); ++rep_)
struct MKArgs { Params p; int ph_lo, ph_hi; };

constexpr int CW_Q0 = 64, CW_Q1 = 128;
__device__ __forceinline__ void q_decode(const Params& p, int kind, int r, TrItem& d) {
    if (kind == 0) { const int e = r >> 9; r &= 511; const int up = r >> 8; r &= 255; const int kb = r >> 3, n0 = 64 * (r & 7);
        d.W = (up ? p.w_up : p.w_gate) + (size_t)e * DM * EFF; d.gain = p.norm2_g; d.WT = p.ws + WS_WGU + (size_t)e * 1024 * DM; d.ldn = EFF; d.ldt = DM; d.kb0 = 64 * kb;
        d.row0 = (n0 >> 7) * 256 + up * 128 + (n0 & 127); d.k0 = 64 * kb; d.n0 = n0; d.fp8 = 1; d.scale = WGU_SCALE; }
    else { const int e = r >> 8; r &= 255; const int kb = r >> 5, n0 = 64 * (r & 31);
        d.W = p.w_down + (size_t)e * EFF * DM; d.gain = nullptr; d.WT = p.ws + WS_WDN + (size_t)e * DM * EFF; d.ldn = DM; d.ldt = EFF; d.kb0 = 64 * kb;
        d.row0 = n0; d.k0 = 64 * kb; d.n0 = n0; d.fp8 = 1; d.scale = WDN_SCALE; }
}
__device__ __forceinline__ void conv_queue(const Params& p, LAS unsigned char* lds, int kind) {
    int tid = threadIdx.x; asm volatile("" : "+v"(tid)); const int lane = tid & 63, wave = __builtin_amdgcn_readfirstlane(tid >> 6);
    unsigned* qctr = (unsigned*)(p.ws + WS_CTL) + (kind ? CW_Q1 : CW_Q0);
    volatile LAS unsigned* slot = (volatile LAS unsigned*)(lds + MISC_OFF) + 16;
    LAS float* scr = (LAS float*)(lds + wave * 16640);
    const int nitems = kind ? NEXP * 256 : NEXP * 512;
    int qk = 0;
#define Q_GRAB(dst) do { if (tid == 0) slot[qk] = atomicAdd(qctr, 8u); __syncthreads(); dst = (int)slot[qk]; qk ^= 1; } while (0)
    __syncthreads();
    int base; Q_GRAB(base);
    TrItem d0; TrRegs r0; bool v0 = (base + wave < nitems);
    if (v0) { q_decode(p, kind, base + wave, d0); tr_load(d0, r0, lane); }
    while (base < nitems) {
        int nb; Q_GRAB(nb);
        TrItem d1; TrRegs r1; const bool v1 = (nb + wave < nitems);
        if (v1) { q_decode(p, kind, nb + wave, d1); tr_load(d1, r1, lane); }
        if (v0) tr_store(d0, r0, scr, lane);
        d0 = d1; r0 = r1; v0 = v1; base = nb;
    }
    __syncthreads();
#undef Q_GRAB
}

__device__ __forceinline__ void p0_decode(const Params& p, int r, TrItem& d) {
    constexpr int NB16 = G1_N16 / 64, NB8 = G1_N8 / 64;
    constexpr int I_IN = 32 * NB16, I_IN8 = 32 * NB8, I_A = 16 * 32, I_R = 16 * 32;
    unsigned char* ws = p.ws; d.fp8 = 0; d.scale = 1.f; d.gain = nullptr;
    if (r < I_IN) { const int nb = NB16, kb = r / nb, n0 = 64 * (r % nb); d.W = p.w_in + 256 * (g1_code_bf16(n0 >> 8) - (n0 >> 8)); d.gain = p.norm1_g; d.WT = ws + WS_WIN; d.ldn = INW; d.ldt = DM * 2; d.kb0 = 128 * kb; d.row0 = n0; d.k0 = 64 * kb; d.n0 = n0; return; } r -= I_IN;
    if (r < I_IN8) { const int kb = r / NB8, nblk = r % NB8; d.gain = p.norm1_g; d.WT = ws + WS_WIN8; d.ldn = INW; d.ldt = DM; d.kb0 = 64 * kb; d.k0 = 64 * kb; d.fp8 = 1; d.scale = WIN8_SCALE;
        if (nblk < G1_LEAD8 / 64) { const int n0 = 64 * nblk; d.W = p.w_in + 256 * (g1_code_fp8(n0 >> 8) - (n0 >> 8)); d.row0 = n0; d.n0 = n0; }
        else { const int n0 = 64 * (nblk - G1_LEAD8 / 64), sec = n0 >> 11, j0 = n0 & 2047;
            d.W = p.w_in + 5632; d.row0 = G1_LEAD8 + (j0 >> 7) * 256 + sec * 128 + (j0 & 127); d.n0 = n0; }
        return; } r -= I_IN8;
    if (r < I_A) { const int kb = r / 32, n0 = 64 * (r % 32); d.W = p.w_a; d.WT = ws + WS_WAR; d.ldn = DM; d.ldt = 4096; d.kb0 = 128 * kb; d.row0 = n0; d.k0 = 64 * kb; d.n0 = n0; return; } r -= I_A;
    if (r < I_R) { const int kb = r / 32, n0 = 64 * (r % 32); d.W = p.w_r; d.WT = ws + WS_WAR; d.ldn = DM; d.ldt = 4096; d.kb0 = 2048 + 128 * kb; d.row0 = n0; d.k0 = 64 * kb; d.n0 = n0; return; } r -= I_R;
    { const int kb = r / 32, n0 = 64 * (r % 32); d.W = p.w_out; d.WT = ws + WS_WOUT; d.ldn = DM; d.ldt = DM * 2; d.kb0 = 128 * kb; d.row0 = n0; d.k0 = 64 * kb; d.n0 = n0; }
}

__device__ __forceinline__ void p0_prologue(const Params& p, LAS unsigned char* lds, int gw, int NGW, int wave, int lane) {
    LAS float* scr = (LAS float*)(lds + wave * 16640);
    unsigned char* ws = p.ws;
    constexpr int NITEMS = 32 * (G1_N16 / 64) + 32 * (G1_N8 / 64) + 16 * 32 + 16 * 32 + 32 * 32;
    { int it = gw; bool have = it < NITEMS; TrItem d0; TrRegs r0;
      if (have) { p0_decode(p, it, d0); tr_load(d0, r0, lane); }
      while (have) { const int itn = it + NGW; const bool hn = itn < NITEMS; TrItem d1; TrRegs r1;
          if (hn) { p0_decode(p, itn, d1); tr_load(d1, r1, lane); }
          tr_store(d0, r0, scr, lane);
          d0 = d1; r0 = r1; it = itn; have = hn; } }
    float* rs1 = (float*)(ws + WS_RS1); bf16_t* XB = (bf16_t*)p.out;
    { int m = gw; pg8::f32x4 v[8];
      if (m < NTOK) { const pg8::f32x4* xr = (const pg8::f32x4*)(p.x + (size_t)m * DM) + 2 * lane;
#pragma unroll
          for (int j = 0; j < 8; ++j) v[j] = __builtin_nontemporal_load(xr + 128 * (j >> 1) + (j & 1)); }
      while (m < NTOK) {
        const int mn = m + NGW; pg8::f32x4 vn[8];
        if (mn < NTOK) { const pg8::f32x4* xr = (const pg8::f32x4*)(p.x + (size_t)mn * DM) + 2 * lane;
#pragma unroll
            for (int j = 0; j < 8; ++j) vn[j] = __builtin_nontemporal_load(xr + 128 * (j >> 1) + (j & 1)); }
        float s = 0.f;
#pragma unroll
        for (int j = 0; j < 8; ++j) s += (v[j].x * v[j].x + v[j].y * v[j].y) + (v[j].z * v[j].z + v[j].w * v[j].w);
        s = wave_sum(s);
        if (lane == 0) rs1[m] = 1.f / sqrtf(s * (1.f / DM) + EPS);
        v4u* o16 = (v4u*)(XB + (size_t)m * DM) + lane;
#pragma unroll
        for (int j = 0; j < 4; ++j) { v4u o; o.x = pk2(v[2 * j].x, v[2 * j].y); o.y = pk2(v[2 * j].z, v[2 * j].w); o.z = pk2(v[2 * j + 1].x, v[2 * j + 1].y); o.w = pk2(v[2 * j + 1].z, v[2 * j + 1].w); o16[64 * j] = o; }
        pg8::u32x2* o8 = (pg8::u32x2*)((unsigned char*)p.out + 64 * MiB + (size_t)m * DM) + lane;
#pragma unroll
        for (int j = 0; j < 4; ++j) { pg8::u32x2 o; o.x = pk4_fp8(v[2 * j].x, v[2 * j].y, v[2 * j].z, v[2 * j].w); o.y = pk4_fp8(v[2 * j + 1].x, v[2 * j + 1].y, v[2 * j + 1].z, v[2 * j + 1].w); o8[64 * j] = o; }
#pragma unroll
        for (int j = 0; j < 8; ++j) v[j] = vn[j];
        m = mn;
      } }
    {
        for (int idx = gw * 64 + lane; idx < 64 * DM; idx += NGW * 64) { const int n = idx >> 11, k = idx & 2047; float w = 0.f;
            if (n < 4) w = p.w_gr[k * 4 + n]; else if (n < 36) w = p.w_er[k * 32 + n - 4];
            w *= p.norm2_g[k]; const bf16_t hi = f2bf(w); const bf16_t lo = f2bf(w - bf2f(hi));
            ((bf16_t*)(ws + WS_WRH))[idx] = hi; ((bf16_t*)(ws + WS_WRL))[idx] = lo; }
    }
    if (gw == 0) { float* lb = (float*)(ws + WS_LB); for (int j = lane; j < HKW; j += 64) { const float l0 = p.lb_logits[j], l1 = p.lb_logits[HKW + j]; lb[j] = 1.f / (1.f + __expf(l1 - l0)); } }
}

__global__ void __launch_bounds__(NWAVES * 64, 2) mk_fwd(MKArgs args) {
    extern __shared__ __attribute__((aligned(16))) unsigned char lds_raw[];
    LAS unsigned char* lds = (LAS unsigned char*)lds_raw;
    const Params& p = args.p;
    const int G = gridDim.x; const int bx = blockIdx.x; const int vcu = (G % 8 == 0) ? (bx % 8) * (G / 8) + bx / 8 : bx;
    const int NGW = G * NWAVES;
    const int lo = args.ph_lo, hi = args.ph_hi;
    const bool fused = (hi - lo) > 1;
    { volatile LAS unsigned* misc = (volatile LAS unsigned*)(lds + MISC_OFF); if (threadIdx.x < 32) misc[threadIdx.x] = 0u; }
    __syncthreads();
    XcdBarrier gbar; gbar.bar = (unsigned*)(p.ws + WS_CTL) + CW_BAR; gbar.x = 0; gbar.st = (volatile LAS unsigned*)(lds + MISC_OFF) + 8;
    if (fused) gbar = xcd_barrier_post((unsigned*)(p.ws + WS_CTL) + CW_BAR, (volatile LAS unsigned*)(lds + MISC_OFF) + 8);
#define SEAM(k) do { if (IN(k) && IN((k) + 1)) { xcd_barrier(gbar); if (REP_MASK & 1024) xcd_barrier(gbar); } } while (0)
#define IN(k) (lo <= (k) && (k) < hi)
#define OPAQUE_TID() int tid2 = threadIdx.x; asm volatile("" : "+v"(tid2)); const int lane2 = tid2 & 63, wave2 = __builtin_amdgcn_readfirstlane(tid2 >> 6)
    REPEAT(0) if (IN(0)) { OPAQUE_TID(); p0_prologue(p, lds, vcu * NWAVES + wave2, NGW, wave2, lane2); }
    SEAM(0);
    REPEAT(1) if (IN(1)) {
        pg8::StaticOrder S; S.init(NTOK, G1_N16, DM * 2, G, bx, p.out, p.ws + WS_WIN, WGM_G1);
        pg8::EpiG1 E{p.ws, (const float*)(p.ws + WS_RS1), (const float*)(p.ws + WS_LB), 0, 1.f};
        pg8::gemm_phase<pg8::EpiG1, pg8::StaticOrder, true, false>(lds, DM, S, E);
        {
            pg8::StaticOrder S8; S8.init(NTOK, G1_N8, DM, G, bx, (const unsigned char*)p.out + 64 * MiB, p.ws + WS_WIN8, WGM_G18);
            pg8::EpiG1 E8{p.ws, (const float*)(p.ws + WS_RS1), (const float*)(p.ws + WS_LB), 1, 1.f / WIN8_SCALE};
            pg8::gemm_phase<pg8::EpiG1, pg8::StaticOrder, true, false, true>(lds, DM, S8, E8);
        }
        if (rep_ == 0) conv_queue(p, lds, 0);
    }
    SEAM(1);
    REPEAT(2) if (IN(2)) {
        if (G == 256) { OPAQUE_TID(); mix::attn_bias_table(p, lds, (vcu >> 5) & 3, tid2); }
        for (int r2 = 0; r2 <= ((REP_MASK >> 12) & 1); ++r2) { OPAQUE_TID(); for (int u = vcu; u < 256; u += G) mix::hg_passA(p, lds, u, tid2, lane2, wave2); }
        for (int r2 = 0; r2 <= ((REP_MASK >> 11) & 1); ++r2) { OPAQUE_TID(); mix::AttnKV KV; if (vcu < 512) mix::attn_kv_load(p, KV, vcu, tid2); for (int u = vcu; u < 512; u += G) mix::attn_unit(p, lds, u, (u + G < 512) ? u + G : -1, KV, tid2, lane2, wave2, G != 256); }
    }
    if (G != 256) SEAM(2);
    REPEAT(3) if (IN(3)) { for (int u = vcu; u < 256; u += G) { OPAQUE_TID(); mix::hg_passC(p, lds, u, tid2, lane2, wave2); } }
    SEAM(3);
    REPEAT(4) if (IN(4)) {
        pg8::StaticOrder S; S.init(NTOK, DM, DM * 2, G, bx, (const unsigned char*)p.out + 64 * MiB, p.ws + WS_WAR, WGM_P4);
        pg8::EpiMix E{(const bf16_t*)(p.ws + WS_SGA), (const bf16_t*)(p.ws + WS_SGB), (bf16_t*)(p.ws + WS_MIX)};
        pg8::gemm_phase<pg8::EpiMix, pg8::StaticOrder, true, false>(lds, DM, S, E);
    }
    SEAM(4);
    REPEAT(5) if (IN(5)) {
        pg8::StaticOrder S; S.init(NTOK, DM, DM * 2, G, bx, p.ws + WS_MIX, p.ws + WS_WOUT, WGM_P5);
        pg8::EpiRes E{(const bf16_t*)p.out, (bf16_t*)(p.ws + WS_XB2), (float*)(p.ws + WS_SS2P), p.ws + WS_XF2};
        int pm0 = -1, pm1 = -1; { pg8::Unit u0; if (S.next(0, u0)) pm0 = u0.pm; if (S.next(1, u0)) pm1 = u0.pm; }
        pg8::gemm_phase<pg8::EpiRes, pg8::StaticOrder, true, false>(lds, DM, S, E);
        if (G == 256 && rep_ == 0) {
            asm volatile("s_waitcnt vmcnt(0)" ::: "memory");
            __syncthreads();
            if (threadIdx.x == 0) { __builtin_amdgcn_fence(__ATOMIC_RELEASE, "agent"); asm volatile("s_waitcnt vmcnt(0)" ::: "memory");
                if (pm0 >= 0) __hip_atomic_fetch_add((unsigned*)(p.ws + WS_CTL) + mix::CW_P5 + 16 * pm0, 1u, __ATOMIC_RELAXED, __HIP_MEMORY_SCOPE_AGENT);
                if (pm1 >= 0) __hip_atomic_fetch_add((unsigned*)(p.ws + WS_CTL) + mix::CW_P5 + 16 * pm1, 1u, __ATOMIC_RELAXED, __HIP_MEMORY_SCOPE_AGENT); }
        }
    }
    if (G != 256) SEAM(5);
    REPEAT(6) if (IN(6)) { OPAQUE_TID();
        for (int u = vcu; u < NTOK / 64; u += G) {
            if (G == 256) {
                if (tid2 == 0) { unsigned* cw = (unsigned*)(p.ws + WS_CTL) + mix::CW_P5 + 16 * (u >> 2); unsigned sp = 0u;
                    while (__hip_atomic_load(cw, __ATOMIC_RELAXED, __HIP_MEMORY_SCOPE_AGENT) < 8u) { __builtin_amdgcn_s_sleep(2); if (++sp > (1u << 22)) break; }
                    __builtin_amdgcn_fence(__ATOMIC_ACQUIRE, "agent"); asm volatile("s_waitcnt vmcnt(0)" ::: "memory"); }
                __syncthreads(); }
            rt::router_unit(p, lds, u, tid2, lane2, wave2, rep_ == ((REP_MASK >> 6) & 1)); } }
    SEAM(6);
    if (IN(7) || IN(8)) {
        LAS int* tab = (LAS int*)(lds + TAB_OFF);
        OPAQUE_TID();
        if (tid2 < 64) {
            const int cnt = (tid2 < 32) ? ((const int*)(p.ws + WS_CTL))[mix::CW_CNT + 32 * tid2] : 0; const int n = (cnt + 255) >> 8; int incl = n;
#pragma unroll
            for (int d = 1; d < 32; d <<= 1) { const int y = __shfl_up(incl, d); if (tid2 >= d) incl += y; }
            if (tid2 < 32) { tab[tid2] = cnt; tab[32 + tid2] = incl - n; }
            if (tid2 == 31) tab[64] = incl; }
        __syncthreads();
    }
    REPEAT(7) if (IN(7)) {
        const LAS int* tab = (const LAS int*)(lds + TAB_OFF);
        pg8::MoeSched1 S; S.tab = tab; S.G = G; S.c = bx; S.nunits = tab[64] * 4; S.xb2 = (const char*)(p.ws + WS_XF2); S.wgu = (const char*)(p.ws + WS_WGU); S.list = (const int*)(p.ws + WS_LIST);
        pg8::EpiMoe1 E{(const int*)(p.ws + WS_LIST), (const float*)(p.ws + WS_LISTR), p.ws + WS_HB};
        pg8::gemm_phase<pg8::EpiMoe1, pg8::MoeSched1, true, true, true>(lds, DM, S, E);
        if (rep_ == 0) conv_queue(p, lds, 1);
    }
    SEAM(7);
    REPEAT(8) if (IN(8)) {
        const LAS int* tab = (const LAS int*)(lds + TAB_OFF);
        pg8::MoeSched2 S; S.tab = tab; S.G = G; S.c = bx; S.nunits = tab[64] * 8; S.hb = (const char*)(p.ws + WS_HB); S.wdn = (const char*)(p.ws + WS_WDN);
        pg8::EpiMoe2 E{(const int*)(p.ws + WS_LIST), (const float*)(p.ws + WS_LISTW), p.ws + WS_YB};
        pg8::gemm_phase<pg8::EpiMoe2, pg8::MoeSched2, true, false, true>(lds, EFF, S, E);
    }
    SEAM(8);
    REPEAT(9) if (IN(9)) {
        OPAQUE_TID(); const int lane = lane2, gw = vcu * NWAVES + wave2;
        const unsigned char* YB = p.ws + WS_YB;
        struct RowRegs { pg8::u32x2 x[8]; unsigned a[8], b[8]; };
        auto load_row = [&](int m, RowRegs& R) {
            const pg8::u32x2* xb = (const pg8::u32x2*)((const bf16_t*)(p.ws + WS_XB2) + (size_t)m * DM) + lane;
            const unsigned* y0 = (const unsigned*)(YB + (size_t)(2 * m) * DM) + lane; const unsigned* y1 = (const unsigned*)(YB + (size_t)(2 * m + 1) * DM) + lane;
#pragma unroll
            for (int j = 0; j < 8; ++j) { R.x[j] = __builtin_nontemporal_load(xb + 64 * j); R.a[j] = __builtin_nontemporal_load(y0 + 64 * j); R.b[j] = __builtin_nontemporal_load(y1 + 64 * j); } };
        pg8::f32x4 gfv[8];
        { const pg8::f32x4* gf = (const pg8::f32x4*)p.final_g + lane;
#pragma unroll
          for (int j = 0; j < 8; ++j) gfv[j] = gf[64 * j]; }
        int m = gw; RowRegs R0; if (m < NTOK) load_row(m, R0);
        while (m < NTOK) {
            const int mn = m + NGW; RowRegs R1; if (mn < NTOK) load_row(mn, R1);
            pg8::f32x4* xr = (pg8::f32x4*)(p.out + (size_t)m * DM) + lane; pg8::f32x4 v[8]; float s = 0.f;
#pragma unroll
            for (int j = 0; j < 8; ++j) { const pg8::u32x2 xw = R0.x[j]; const int a = (int)R0.a[j], b = (int)R0.b[j]; constexpr float ys = 1.f / YB_SCALE;
                v[j].x = __uint_as_float(xw.x << 16) + (__builtin_amdgcn_cvt_f32_fp8(a, 0) + __builtin_amdgcn_cvt_f32_fp8(b, 0)) * ys; v[j].y = __uint_as_float(xw.x & 0xffff0000u) + (__builtin_amdgcn_cvt_f32_fp8(a, 1) + __builtin_amdgcn_cvt_f32_fp8(b, 1)) * ys;
                v[j].z = __uint_as_float(xw.y << 16) + (__builtin_amdgcn_cvt_f32_fp8(a, 2) + __builtin_amdgcn_cvt_f32_fp8(b, 2)) * ys; v[j].w = __uint_as_float(xw.y & 0xffff0000u) + (__builtin_amdgcn_cvt_f32_fp8(a, 3) + __builtin_amdgcn_cvt_f32_fp8(b, 3)) * ys;
                s += (v[j].x * v[j].x + v[j].y * v[j].y) + (v[j].z * v[j].z + v[j].w * v[j].w); }
            s = wave_sum(s);
            const float rstd = 1.f / sqrtf(s * (1.f / DM) + EPS);
#pragma unroll
            for (int j = 0; j < 8; ++j) __builtin_nontemporal_store(v[j] * rstd * gfv[j], xr + 64 * j);
            R0 = R1; m = mn;
        }
    }
#undef IN
}

extern "C" void kernel_launch(void* const* d_in, const int* in_sizes, int n_in, void* d_out, int out_size, void* d_ws, size_t ws_size, hipStream_t stream) {
    if (n_in != 19 || out_size != NTOK * DM || ws_size < WS_END) { fprintf(stderr, "kernel_launch: unexpected sizes n_in=%d out=%d ws=%zu\n", n_in, out_size, ws_size); return; }
    static int grid = 0;
    if (grid == 0) {
        int dev = 0, cus = 0, per_cu = 0;
        hipGetDevice(&dev); hipDeviceGetAttribute(&cus, hipDeviceAttributeMultiprocessorCount, dev);
        hipFuncSetAttribute((const void*)mk_fwd, hipFuncAttributeMaxDynamicSharedMemorySize, LDS_BYTES);
        hipOccupancyMaxActiveBlocksPerMultiprocessor(&per_cu, (const void*)mk_fwd, NWAVES * 64, LDS_BYTES);
        (void)hipGetLastError();
        if (per_cu < 1) per_cu = 1;
        grid = cus * per_cu;
        fprintf(stderr, "kernel_launch: cus=%d per_cu=%d grid=%d\n", cus, per_cu, grid);
    }
    Params p{};
    const float** pp = (const float**)&p;
    for (int i = 0; i < 19; ++i) pp[i] = (const float*)d_in[i];
    p.out = (float*)d_out; p.ws = (unsigned char*)d_ws;
    hipMemsetAsync((char*)d_ws + WS_CTL, 0, 40960, stream);
    MKArgs a{}; a.p = p;
    a.ph_lo = 0; a.ph_hi = 10;
    void* kargs[] = {&a};
    hipError_t e = hipLaunchCooperativeKernel((const void*)mk_fwd, dim3(grid), dim3(NWAVES * 64), kargs, LDS_BYTES, stream);
    if (e != hipSuccess) fprintf(stderr, "cooperative launch failed: %s (grid %d)\n", hipGetErrorString(e), grid);
}
```
